# Optimizing an MI355X kernel written in HIP

```python
import math
import jax, jax.numpy as jnp
from jax import lax
import numpy as np

D_MODEL = 1024
BATCH = 8
SEQ = 2048
DEPTH = 2

CHUNK = 64
PLE_DIM = 256
CONV_WIDTH = 4
EPS = 1e-5
ROPE_BASE = 10000.0

MIX_HALF = D_MODEL // 2
MIX_OUT = 2 * MIX_HALF
LRU_WIDTH = MIX_HALF
LRU_BLOCKS = 8
LRU_BLOCK = LRU_WIDTH // LRU_BLOCKS
LRU_C = 8.0
RET_HEADS = 4
RET_DIM = MIX_HALF // RET_HEADS
SSD_WIDTH = MIX_HALF
SSD_HEADDIM = 64
SSD_HEADS = SSD_WIDTH // SSD_HEADDIM
SSD_GROUPS = 2
SSD_STATE = 128
SSD_XBC = SSD_WIDTH + 2 * SSD_GROUPS * SSD_STATE
HGRN_WIDTH = MIX_HALF
HGRN_HEADS = 4
HGRN_KDIM = HGRN_WIDTH // HGRN_HEADS
HGRN_VDIM = HGRN_WIDTH // HGRN_HEADS

EVEN_IN = 2 * LRU_WIDTH + 4 * MIX_HALF
ODD_IN = SSD_WIDTH + SSD_XBC + SSD_HEADS + 4 * HGRN_WIDTH

N_GROUPS = 4
EXPERTS_PER_GROUP = 4
N_EXPERTS = N_GROUPS * EXPERTS_PER_GROUP
EXPERT_FF = 256
TOP_K_IN_GROUP = 2

N_EVEN = (DEPTH + 1) // 2
N_ODD = DEPTH // 2
DEEPNORM_ALPHA = (2.0 * DEPTH) ** 0.25
DEEPNORM_BETA = (8.0 * DEPTH) ** -0.25

kernel_name = "hybrid_chunk_causal_trunk"


def layer_norm(x, g, b):
    xf = x.astype(jnp.float32)
    mu = jnp.mean(xf, -1, keepdims=True)
    var = jnp.mean(jnp.square(xf - mu), -1, keepdims=True)
    return ((xf - mu) * lax.rsqrt(var + EPS) * g + b).astype(x.dtype)


def rms_norm_groups(x, w, n_groups):
    shp = x.shape
    xf = x.astype(jnp.float32).reshape(shp[:-1] + (n_groups, shp[-1] // n_groups))
    xf = xf * lax.rsqrt(jnp.mean(jnp.square(xf), -1, keepdims=True) + EPS)
    return (xf.reshape(shp) * w).astype(x.dtype)


def head_group_norm(x, w, n_heads):
    shp = x.shape
    xf = x.astype(jnp.float32).reshape(shp[:-1] + (n_heads, shp[-1] // n_heads))
    mu = jnp.mean(xf, -1, keepdims=True)
    xf = (xf - mu) * lax.rsqrt(jnp.mean(jnp.square(xf - mu), -1, keepdims=True) + EPS)
    return xf.reshape(shp) * w


def causal_depthwise_conv(x, w, b):
    s = x.shape[1]
    xp = jnp.pad(x, ((0, 0), (CONV_WIDTH - 1, 0), (0, 0)))
    y = b
    for k in range(CONV_WIDTH):
        y = y + xp[:, k:k + s, :] * w[k]
    return y


def rotary(x, positions):
    d = x.shape[-1]
    inv = ROPE_BASE ** (-jnp.arange(0, d, 2, dtype=jnp.float32) / d)
    ang = positions.astype(jnp.float32)[..., None] * inv
    cos = jnp.cos(ang)[:, :, None, :]
    sin = jnp.sin(ang)[:, :, None, :]
    xf = x.astype(jnp.float32)
    x1, x2 = xf[..., :d // 2], xf[..., d // 2:]
    return jnp.concatenate([x1 * cos - x2 * sin, x2 * cos + x1 * sin], -1)


def to_chunks(x):
    bsz, s, h, d = x.shape
    return x.reshape(bsz, s // CHUNK, CHUNK, h, d).transpose(0, 3, 1, 2, 4)


def from_chunks(x):
    bsz, h, nc, c, d = x.shape
    return x.transpose(0, 2, 3, 1, 4).reshape(bsz, nc * c, h * d)


def rg_lru_mixer(xa, ya, conv_w, conv_b, w_r, b_r, w_i, b_i, lam):
    bsz, s, _ = xa.shape
    xc = causal_depthwise_conv(xa, conv_w, conv_b)
    xb = xc.reshape(bsz, s, LRU_BLOCKS, LRU_BLOCK)
    r = jax.nn.sigmoid(jnp.einsum('bshi,hij->bshj', xb, w_r).reshape(bsz, s, LRU_WIDTH) + b_r)
    gi = jax.nn.sigmoid(jnp.einsum('bshi,hij->bshj', xb, w_i).reshape(bsz, s, LRU_WIDTH) + b_i)
    log_a = -LRU_C * r.astype(jnp.float32) * jax.nn.softplus(-lam.astype(jnp.float32))
    a = jnp.exp(log_a)
    u = jnp.sqrt(-jnp.expm1(2.0 * log_a)) * (gi * xc).astype(jnp.float32)

    def combine(c1, c2):
        a1, b1 = c1
        a2, b2 = c2
        return a1 * a2, a2 * b1 + b2

    _, h = lax.associative_scan(combine, (a, u), axis=1)
    return (h.astype(xa.dtype) * jax.nn.gelu(ya)).astype(xa.dtype)


def retention_mixer(q, k, v, g, positions, gn_w):
    bsz, s, _ = q.shape
    q = rotary(q.reshape(bsz, s, RET_HEADS, RET_DIM), positions)
    k = rotary(k.reshape(bsz, s, RET_HEADS, RET_DIM), positions) * (RET_DIM ** -0.5)
    v = v.reshape(bsz, s, RET_HEADS, RET_DIM).astype(jnp.float32)
    qc, kc, vc = to_chunks(q), to_chunks(k), to_chunks(v)
    log_gamma = jnp.log1p(-(2.0 ** (-5.0 - jnp.arange(RET_HEADS, dtype=jnp.float32))))
    idx = jnp.arange(CHUNK, dtype=jnp.float32)
    decay_intra = jnp.exp(log_gamma[:, None, None] * jnp.abs(idx[:, None] - idx[None, :]))
    scores = jnp.einsum('bhnid,bhnjd->bhnij', qc, kc) * decay_intra[:, None]
    o_intra = jnp.einsum('bhnij,bhnje->bhnie', scores, vc)
    k_to_end = kc * jnp.exp(log_gamma[:, None] * (CHUNK - 1 - idx))[:, None, :, None]
    chunk_kv = jnp.einsum('bhnjd,bhnje->nbhde', k_to_end, vc)
    chunk_decay = jnp.exp(log_gamma * CHUNK)[:, None, None]

    def step(state, kv):
        return chunk_decay * state + kv, state

    _, prev = lax.scan(step, jnp.zeros_like(chunk_kv[0]), chunk_kv)
    q_from_start = qc * jnp.exp(log_gamma[:, None] * (idx + 1.0))[:, None, :, None]
    o_inter = jnp.einsum('bhnid,nbhde->bhnie', q_from_start, prev)
    o = head_group_norm(from_chunks(o_intra + o_inter), gn_w, RET_HEADS)
    return (jax.nn.silu(g.astype(jnp.float32)) * o).astype(g.dtype)


def ssd_mixer(z, xbc, dt, conv_w, conv_b, dt_bias, a_log, d_skip, norm_w):
    bsz, s, _ = z.shape
    xbc = jax.nn.silu(causal_depthwise_conv(xbc, conv_w, conv_b))
    xs = xbc[..., :SSD_WIDTH].reshape(bsz, s, SSD_HEADS, SSD_HEADDIM)
    bm = xbc[..., SSD_WIDTH:SSD_WIDTH + SSD_GROUPS * SSD_STATE].reshape(bsz, s, SSD_GROUPS, SSD_STATE)
    cm = xbc[..., SSD_WIDTH + SSD_GROUPS * SSD_STATE:].reshape(bsz, s, SSD_GROUPS, SSD_STATE)
    heads_per_group = SSD_HEADS // SSD_GROUPS
    bm = jnp.repeat(bm, heads_per_group, axis=2)
    cm = jnp.repeat(cm, heads_per_group, axis=2)
    dt = jax.nn.softplus(dt.astype(jnp.float32) + dt_bias)
    a = -jnp.exp(a_log.astype(jnp.float32))
    xc = to_chunks(xs.astype(jnp.float32))
    bc = to_chunks(bm.astype(jnp.float32))
    cc = to_chunks(cm.astype(jnp.float32))
    dtc = to_chunks(dt[..., None])[..., 0]
    cs = jnp.cumsum(dtc * a[None, :, None, None], axis=-1)
    causal = jnp.arange(CHUNK)[:, None] >= jnp.arange(CHUNK)[None, :]
    seg = jnp.exp(jnp.where(causal, cs[..., :, None] - cs[..., None, :], -jnp.inf))
    scores = jnp.einsum('bhnid,bhnjd->bhnij', cc, bc) * seg
    y_intra = jnp.einsum('bhnij,bhnjp->bhnip', scores, xc * dtc[..., None])
    decay_to_end = jnp.exp(cs[..., -1:] - cs)
    chunk_states = jnp.einsum('bhnjd,bhnjp->nbhpd', bc * (decay_to_end * dtc)[..., None], xc)
    chunk_decay = jnp.exp(cs[..., -1]).transpose(2, 0, 1)

    def step(state, inp):
        st, dec = inp
        return dec[..., None, None] * state + st, state

    _, prev = lax.scan(step, jnp.zeros_like(chunk_states[0]), (chunk_states, chunk_decay))
    y_inter = jnp.einsum('bhnid,nbhpd->bhnip', cc * jnp.exp(cs)[..., None], prev)
    y = from_chunks(y_intra + y_inter) + (xs.astype(jnp.float32) * d_skip[:, None]).reshape(bsz, s, SSD_WIDTH)
    y = y.astype(z.dtype)
    return rms_norm_groups(y * jax.nn.silu(z), norm_w, SSD_GROUPS)


def hgrn2_mixer(q, f_raw, i_in, g, lower_bound, norm_w):
    bsz, s, _ = q.shape
    qf = jax.nn.silu(q.astype(jnp.float32))
    f = lower_bound + (1.0 - lower_bound) * jax.nn.sigmoid(f_raw.astype(jnp.float32))
    kf = 1.0 - f
    shp = (bsz, s, HGRN_HEADS, HGRN_KDIM)
    qc = to_chunks(qf.reshape(shp))
    kc = to_chunks(kf.reshape(shp))
    bc = jnp.cumsum(to_chunks(jnp.log(f).reshape(shp)), axis=3)
    vc = to_chunks(i_in.astype(jnp.float32).reshape(bsz, s, HGRN_HEADS, HGRN_VDIM))
    xs = tuple(t.transpose(2, 0, 1, 3, 4) for t in (qc, kc, vc, bc))
    causal = jnp.arange(CHUNK)[:, None] >= jnp.arange(CHUNK)[None, :]

    def step(state, inp):
        qn, kn, vn, bn = inp
        rel = bn[:, :, :, None, :] - bn[:, :, None, :, :]
        w = jnp.exp(jnp.where(causal[..., None], rel, -jnp.inf))
        scores = jnp.einsum('bhik,bhjk,bhijk->bhij', qn, kn, w)
        o = jnp.einsum('bhij,bhjv->bhiv', scores, vn) + jnp.einsum('bhik,bhkv->bhiv', qn * jnp.exp(bn), state)
        b_end = bn[:, :, -1:, :]
        new_state = jnp.exp(b_end[:, :, 0, :])[..., None] * state + jnp.einsum('bhjk,bhjv->bhkv', kn * jnp.exp(b_end - bn), vn)
        return new_state, o

    state0 = jnp.zeros((bsz, HGRN_HEADS, HGRN_KDIM, HGRN_VDIM), jnp.float32)
    _, o = lax.scan(step, state0, xs)
    o = from_chunks(o.transpose(1, 2, 0, 3, 4)).astype(q.dtype)
    return (rms_norm_groups(o, norm_w, HGRN_HEADS) * jax.nn.silu(g)).astype(q.dtype)


def hierarchical_moe(x, w_group, b_group, w_router, b_router, w1, w3, w2):
    bsz, s, d = x.shape
    t = x.reshape(bsz * s, d)
    group_logits = (t @ w_group + b_group).astype(jnp.float32)
    group_probs = jax.nn.softmax(group_logits, -1)
    g_sel = jnp.argmax(group_logits, -1)
    p_group = jnp.max(group_probs, -1, keepdims=True)
    g_onehot = jax.nn.one_hot(g_sel, N_GROUPS, dtype=jnp.float32)
    expert_logits = (jnp.einsum('td,gde->tge', t, w_router) + b_router).astype(jnp.float32)
    in_group = jnp.einsum('tge,tg->te', expert_logits, g_onehot)
    top_val, top_idx = lax.top_k(in_group, TOP_K_IN_GROUP)
    top_w = jax.nn.softmax(top_val, -1) * p_group
    expert_id = g_sel[:, None] * EXPERTS_PER_GROUP + top_idx
    gate = jnp.sum(jax.nn.one_hot(expert_id, N_EXPERTS, dtype=jnp.float32) * top_w[..., None], axis=1)
    h = jax.nn.silu(jnp.einsum('td,edf->tef', t, w1)) * jnp.einsum('td,edf->tef', t, w3)
    y = jnp.einsum('tef,efd->td', h * gate[..., None].astype(h.dtype), w2)
    return y.reshape(bsz, s, d).astype(x.dtype)


def setup_inputs(seed: int = 0) -> dict:
    key = jax.random.key(seed)
    ks = iter(jax.random.split(key, 48))

    def nrm(shape, scale):
        return jax.random.normal(next(ks), shape, jnp.float32) * scale

    def ones_noise(shape):
        return 1.0 + nrm(shape, 0.01)

    x = nrm((BATCH, SEQ, D_MODEL), 1.0)
    p = nrm((DEPTH, BATCH, SEQ, PLE_DIM), 1.0)
    offsets = jax.random.randint(next(ks), (BATCH, 1), 0, 64, dtype=jnp.int32) * CHUNK
    positions = (offsets + jnp.arange(SEQ, dtype=jnp.int32)[None, :]).astype(jnp.int32)
    hgrn_lb_logits = nrm((DEPTH, HGRN_WIDTH), 0.5)

    ev_w_in = nrm((N_EVEN, D_MODEL, EVEN_IN), D_MODEL ** -0.5)
    ev_w_out = nrm((N_EVEN, MIX_OUT, D_MODEL), MIX_OUT ** -0.5 * DEEPNORM_BETA)
    lru_conv_w = nrm((N_EVEN, CONV_WIDTH, LRU_WIDTH), CONV_WIDTH ** -0.5)
    lru_conv_b = nrm((N_EVEN, LRU_WIDTH), 0.01)
    lru_w_r = nrm((N_EVEN, LRU_BLOCKS, LRU_BLOCK, LRU_BLOCK), LRU_BLOCK ** -0.5)
    lru_b_r = nrm((N_EVEN, LRU_WIDTH), 0.01)
    lru_w_i = nrm((N_EVEN, LRU_BLOCKS, LRU_BLOCK, LRU_BLOCK), LRU_BLOCK ** -0.5)
    lru_b_i = nrm((N_EVEN, LRU_WIDTH), 0.01)
    u = jax.random.uniform(next(ks), (N_EVEN, LRU_WIDTH), jnp.float32, 0.9, 0.999)
    a0 = u ** (1.0 / LRU_C)
    lru_lambda = jnp.log(a0) - jnp.log1p(-a0)
    ret_gn_w = ones_noise((N_EVEN, MIX_HALF))

    od_w_in = nrm((N_ODD, D_MODEL, ODD_IN), D_MODEL ** -0.5)
    od_w_out = nrm((N_ODD, MIX_OUT, D_MODEL), MIX_OUT ** -0.5 * DEEPNORM_BETA)
    ssd_conv_w = nrm((N_ODD, CONV_WIDTH, SSD_XBC), CONV_WIDTH ** -0.5)
    ssd_conv_b = nrm((N_ODD, SSD_XBC), 0.01)
    dt0 = jnp.exp(jax.random.uniform(next(ks), (N_ODD, SSD_HEADS), jnp.float32, math.log(1e-3), math.log(1e-1)))
    ssd_dt_bias = dt0 + jnp.log(-jnp.expm1(-dt0))
    ssd_a_log = jnp.log(jax.random.uniform(next(ks), (N_ODD, SSD_HEADS), jnp.float32, 1.0, 16.0))
    ssd_d = ones_noise((N_ODD, SSD_HEADS))
    ssd_norm_w = ones_noise((N_ODD, SSD_WIDTH))
    hgrn_norm_w = ones_noise((N_ODD, HGRN_WIDTH))

    ln_mix_g = ones_noise((DEPTH, D_MODEL))
    ln_mix_b = nrm((DEPTH, D_MODEL), 0.01)
    ln_ffn_g = ones_noise((DEPTH, D_MODEL))
    ln_ffn_b = nrm((DEPTH, D_MODEL), 0.01)

    moe_w_group = nrm((DEPTH, D_MODEL, N_GROUPS), D_MODEL ** -0.5)
    moe_b_group = nrm((DEPTH, N_GROUPS), 0.01)
    moe_w_router = nrm((DEPTH, N_GROUPS, D_MODEL, EXPERTS_PER_GROUP), D_MODEL ** -0.5)
    moe_b_router = nrm((DEPTH, N_GROUPS, EXPERTS_PER_GROUP), 0.01)
    moe_w1 = nrm((DEPTH, N_EXPERTS, D_MODEL, EXPERT_FF), D_MODEL ** -0.5)
    moe_w3 = nrm((DEPTH, N_EXPERTS, D_MODEL, EXPERT_FF), D_MODEL ** -0.5)
    moe_w2 = nrm((DEPTH, N_EXPERTS, EXPERT_FF, D_MODEL), EXPERT_FF ** -0.5 * DEEPNORM_BETA)

    ple_w_proj = nrm((DEPTH, PLE_DIM, D_MODEL), PLE_DIM ** -0.5)
    ple_w_gate = nrm((DEPTH, D_MODEL, D_MODEL), D_MODEL ** -0.5)

    return {"x": x, "p": p, "positions": positions, "hgrn_lb_logits": hgrn_lb_logits,
            "ev_w_in": ev_w_in, "ev_w_out": ev_w_out, "lru_conv_w": lru_conv_w, "lru_conv_b": lru_conv_b,
            "lru_w_r": lru_w_r, "lru_b_r": lru_b_r, "lru_w_i": lru_w_i, "lru_b_i": lru_b_i,
            "lru_lambda": lru_lambda, "ret_gn_w": ret_gn_w,
            "od_w_in": od_w_in, "od_w_out": od_w_out, "ssd_conv_w": ssd_conv_w, "ssd_conv_b": ssd_conv_b,
            "ssd_dt_bias": ssd_dt_bias, "ssd_a_log": ssd_a_log, "ssd_d": ssd_d, "ssd_norm_w": ssd_norm_w,
            "hgrn_norm_w": hgrn_norm_w,
            "ln_mix_g": ln_mix_g, "ln_mix_b": ln_mix_b, "ln_ffn_g": ln_ffn_g, "ln_ffn_b": ln_ffn_b,
            "moe_w_group": moe_w_group, "moe_b_group": moe_b_group, "moe_w_router": moe_w_router,
            "moe_b_router": moe_b_router, "moe_w1": moe_w1, "moe_w3": moe_w3, "moe_w2": moe_w2,
            "ple_w_proj": ple_w_proj, "ple_w_gate": ple_w_gate}


def reference(x, p, positions, hgrn_lb_logits,
              ev_w_in, ev_w_out, lru_conv_w, lru_conv_b, lru_w_r, lru_b_r, lru_w_i, lru_b_i,
              lru_lambda, ret_gn_w,
              od_w_in, od_w_out, ssd_conv_w, ssd_conv_b, ssd_dt_bias, ssd_a_log, ssd_d, ssd_norm_w,
              hgrn_norm_w,
              ln_mix_g, ln_mix_b, ln_ffn_g, ln_ffn_b,
              moe_w_group, moe_b_group, moe_w_router, moe_b_router, moe_w1, moe_w3, moe_w2,
              ple_w_proj, ple_w_gate):
    lb_soft = jax.nn.softmax(hgrn_lb_logits.astype(jnp.float32), axis=0)
    lb_all = jnp.cumsum(lb_soft, axis=0) - lb_soft[0]
    h = x
    for i in range(DEPTH):
        j = i // 2
        if i % 2 == 0:
            u = h @ ev_w_in[j]
            xa, ya, q, k, v, g = jnp.split(u, [LRU_WIDTH, 2 * LRU_WIDTH, 2 * LRU_WIDTH + MIX_HALF,
                                               2 * LRU_WIDTH + 2 * MIX_HALF, 2 * LRU_WIDTH + 3 * MIX_HALF], axis=-1)
            out_a = rg_lru_mixer(xa, ya, lru_conv_w[j], lru_conv_b[j], lru_w_r[j], lru_b_r[j],
                                 lru_w_i[j], lru_b_i[j], lru_lambda[j])
            out_b = retention_mixer(q, k, v, g, positions, ret_gn_w[j])
            mix = jnp.concatenate([out_a, out_b], axis=-1) @ ev_w_out[j]
        else:
            u = h @ od_w_in[j]
            c0 = SSD_WIDTH
            c1 = c0 + SSD_XBC
            c2 = c1 + SSD_HEADS
            z, xbc, dt, q, f_raw, i_in, g = jnp.split(u, [c0, c1, c2, c2 + HGRN_WIDTH, c2 + 2 * HGRN_WIDTH,
                                                          c2 + 3 * HGRN_WIDTH], axis=-1)
            out_c = ssd_mixer(z, xbc, dt, ssd_conv_w[j], ssd_conv_b[j], ssd_dt_bias[j], ssd_a_log[j],
                              ssd_d[j], ssd_norm_w[j])
            out_d = hgrn2_mixer(q, f_raw, i_in, g, lb_all[i], hgrn_norm_w[j])
            mix = jnp.concatenate([out_c, out_d], axis=-1) @ od_w_out[j]
        h = layer_norm(DEEPNORM_ALPHA * h + mix, ln_mix_g[i], ln_mix_b[i])
        moe = hierarchical_moe(h, moe_w_group[i], moe_b_group[i], moe_w_router[i], moe_b_router[i],
                               moe_w1[i], moe_w3[i], moe_w2[i])
        h = layer_norm(DEEPNORM_ALPHA * h + moe, ln_ffn_g[i], ln_ffn_b[i])
        h = (h + (p[i] @ ple_w_proj[i]) * jax.nn.sigmoid(h @ ple_w_gate[i])).astype(x.dtype)
    return h
```

```cpp
#include <hip/hip_runtime.h>
#include <stdint.h>
#include <string.h>

#define DI __device__ __forceinline__
typedef unsigned short bf16_t;
typedef short bf16x8 __attribute__((ext_vector_type(8)));
typedef float f32x16 __attribute__((ext_vector_type(16)));
typedef float f32x4 __attribute__((ext_vector_type(4)));
typedef unsigned u32x4 __attribute__((ext_vector_type(4)));
typedef unsigned u32x2 __attribute__((ext_vector_type(2)));
#define MFMA32(a, b, c) __builtin_amdgcn_mfma_f32_32x32x16_bf16((a), (b), (c), 0, 0, 0)

constexpr int T_TOK = 16384, DM = 1024, SEQ = 2048, NCH = 32;
constexpr float ALPHA = 1.41421356237f;
constexpr float EPS = 1e-5f;
constexpr int NPH = 11;

constexpr size_t MiB = 1048576;
constexpr size_t OFF_W = 0;
constexpr size_t OFF_HB = 37 * MiB;
constexpr size_t OFF_U = 69 * MiB;
constexpr size_t OFF_Y = 69 * MiB;
constexpr size_t OFF_H1B = 133 * MiB;
constexpr size_t OFF_PB = 165 * MiB;
constexpr size_t OFF_ST = 185 * MiB;
constexpr size_t OFF_SM = 249 * MiB;
constexpr size_t WS_NEED = 256 * MiB;
constexpr size_t W_WIN = 0, W_WOUT = 7602176, W_W13 = 9699328, W_W2 = 26476544, W_WP = 34865152, W_WG = 35389440,
                 W_WRT = 37486592, W_WIT = 37552128, W_RW = 37617664;
constexpr size_t SM_BAR = 0;
constexpr size_t SM_CNT = 16384;
constexpr size_t SM_SUMA = 32768;
constexpr size_t SM_SUMH = SM_SUMA + 524288;
constexpr size_t SM_CD = SM_SUMH + 524288;
constexpr size_t SM_HD = SM_CD + 8192;
constexpr size_t SM_DT = SM_HD + 524288;
constexpr size_t SM_LIST = SM_DT + 524288;
constexpr size_t SM_GATE = SM_LIST + 1048576;

struct Params {
  const float *x, *p; const int* pos; const float* lb_logits;
  const float *ev_w_in, *ev_w_out, *lru_conv_w, *lru_conv_b, *lru_w_r, *lru_b_r, *lru_w_i, *lru_b_i, *lru_lambda, *ret_gn_w;
  const float *od_w_in, *od_w_out, *ssd_conv_w, *ssd_conv_b, *ssd_dt_bias, *ssd_a_log, *ssd_d, *ssd_norm_w, *hgrn_norm_w;
  const float *ln_mix_g, *ln_mix_b, *ln_ffn_g, *ln_ffn_b;
  const float *moe_w_group, *moe_b_group, *moe_w_router, *moe_b_router, *moe_w1, *moe_w3, *moe_w2, *ple_w_proj, *ple_w_gate;
  float* out; char* ws;
};

DI float bf2f(bf16_t v) { return __uint_as_float((unsigned)v << 16); }
DI bf16_t f2bf(float x) { unsigned u = __float_as_uint(x); u += 0x7fffu + ((u >> 16) & 1u); return (bf16_t)(u >> 16); }
DI unsigned pack2(float lo, float hi) { return (unsigned)f2bf(lo) | ((unsigned)f2bf(hi) << 16); }
DI void unpack8(u32x4 v, float (&f)[8]) {
  f[0] = __uint_as_float(v.x << 16); f[1] = __uint_as_float(v.x & 0xffff0000u);
  f[2] = __uint_as_float(v.y << 16); f[3] = __uint_as_float(v.y & 0xffff0000u);
  f[4] = __uint_as_float(v.z << 16); f[5] = __uint_as_float(v.z & 0xffff0000u);
  f[6] = __uint_as_float(v.w << 16); f[7] = __uint_as_float(v.w & 0xffff0000u);
}
DI u32x4 pack8(const float (&f)[8]) { u32x4 v; v.x = pack2(f[0], f[1]); v.y = pack2(f[2], f[3]); v.z = pack2(f[4], f[5]); v.w = pack2(f[6], f[7]); return v; }
DI float sigmoidf_(float x) { return 1.0f / (1.0f + __expf(-x)); }
DI float siluf_(float x) { return x * sigmoidf_(x); }
DI float log1p_(float x) { const float u = 1.0f + x, d = u - 1.0f; return d == 0.f ? x : __logf(u) * (x / d); }
DI float softplusf_(float x) { return x > 20.f ? x : log1p_(__expf(x)); }
DI float neg_expm1_(float x) {
  if (x < -0.5f) return 1.0f - __expf(x);
  float p = 1.0f / 5040.0f;
  p = fmaf(p, x, 1.0f / 720.0f); p = fmaf(p, x, 1.0f / 120.0f); p = fmaf(p, x, 1.0f / 24.0f); p = fmaf(p, x, 1.0f / 6.0f); p = fmaf(p, x, 0.5f); p = fmaf(p, x, 1.0f);
  return -x * p;
}
DI float geluf_(float x) { const float u = 0.7978845608028654f * (x + 0.044715f * x * x * x); const float t = 1.0f - 2.0f / (__expf(2.0f * u) + 1.0f); return 0.5f * x * (1.0f + t); }
DI int crow(int r, int h) { return (r & 3) + 8 * (r >> 2) + 4 * h; }
DI void sincos_rr(float x, float& s, float& c) {
  const float n = rintf(x * 0.15915494309189535f);
  float r = fmaf(-n, 6.28125f, x);
  r = fmaf(-n, 1.9353071795864769e-3f, r);
  s = __sinf(r); c = __cosf(r);
}
DI float wave_sum(float v) {
#pragma unroll
  for (int o = 32; o >= 1; o >>= 1) v += __shfl_xor(v, o);
  return v;
}
DI f32x16 zero16() { f32x16 z; for (int i = 0; i < 16; ++i) z[i] = 0.f; return z; }

template <int WM, int WN, int KT>
DI void wave_mma(f32x16 (&acc)[WM][WN], const bf16_t* A, int lda, const bf16_t* B, int ldb, int lane) {
  const int r = lane & 31, h = lane >> 5;
  const bf16_t* ap = A + r * lda + 8 * h;
  const bf16_t* bp = B + r * ldb + 8 * h;
#pragma unroll
  for (int k0 = 0; k0 < KT; k0 += 16) {
    bf16x8 a[WM], b[WN];
#pragma unroll
    for (int m = 0; m < WM; ++m) a[m] = *(const bf16x8*)(ap + m * 32 * lda + k0);
#pragma unroll
    for (int n = 0; n < WN; ++n) b[n] = *(const bf16x8*)(bp + n * 32 * ldb + k0);
#pragma unroll
    for (int m = 0; m < WM; ++m)
#pragma unroll
      for (int n = 0; n < WN; ++n) acc[m][n] = MFMA32(a[m], b[n], acc[m][n]);
  }
}

constexpr int G_LD = 72;
constexpr int G_TILE = 128 * G_LD * 2;
DI void gemm_mainloop(f32x16 (&acc)[2][2], const bf16_t* (&arow)[4], const bf16_t* (&brow)[4], int K, char* smem, int tid) {
  const int lane = tid & 63, w = tid >> 6, wm = w >> 1, wn = w & 1;
  const int srow = tid >> 3, skc = tid & 7;
  u32x4 ra[4], rb[4];
#pragma unroll
  for (int i = 0; i < 4; ++i) { ra[i] = *(const u32x4*)(arow[i]); rb[i] = *(const u32x4*)(brow[i]); }
#pragma unroll
  for (int i = 0; i < 4; ++i) {
    *(u32x4*)(smem + ((srow + 32 * i) * G_LD + skc * 8) * 2) = ra[i];
    *(u32x4*)(smem + G_TILE + ((srow + 32 * i) * G_LD + skc * 8) * 2) = rb[i];
  }
  __syncthreads();
  const int nk = K >> 6;
  for (int kt = 0; kt < nk; ++kt) {
    const int cur = kt & 1;
    if (kt + 1 < nk) {
#pragma unroll
      for (int i = 0; i < 4; ++i) { ra[i] = *(const u32x4*)(arow[i] + (kt + 1) * 64); rb[i] = *(const u32x4*)(brow[i] + (kt + 1) * 64); }
    }
    const bf16_t* As = (const bf16_t*)(smem + cur * 2 * G_TILE) + wm * 64 * G_LD;
    const bf16_t* Bs = (const bf16_t*)(smem + cur * 2 * G_TILE + G_TILE) + wn * 64 * G_LD;
    wave_mma<2, 2, 64>(acc, As, G_LD, Bs, G_LD, lane);
    if (kt + 1 < nk) {
      char* nb = smem + (cur ^ 1) * 2 * G_TILE;
#pragma unroll
      for (int i = 0; i < 4; ++i) {
        *(u32x4*)(nb + ((srow + 32 * i) * G_LD + skc * 8) * 2) = ra[i];
        *(u32x4*)(nb + G_TILE + ((srow + 32 * i) * G_LD + skc * 8) * 2) = rb[i];
      }
    }
    __syncthreads();
  }
}

DI void tr_tile(const float* src, int ld, int col0, int valid, int k0, bf16_t* dst, int K, int n0, char* smem, int tid) {
  bf16_t* t = (bf16_t*)smem;
  __syncthreads();
  const int kk = tid >> 3, c4 = tid & 7;
#pragma unroll
  for (int pss = 0; pss < 2; ++pss) {
    const int k = kk + 32 * pss;
    f32x4 v = {0.f, 0.f, 0.f, 0.f};
    if (4 * c4 < valid) v = *(const f32x4*)(src + (size_t)(k0 + k) * ld + col0 + 4 * c4);
    t[(4 * c4 + 0) * 72 + k] = f2bf(v[0]); t[(4 * c4 + 1) * 72 + k] = f2bf(v[1]);
    t[(4 * c4 + 2) * 72 + k] = f2bf(v[2]); t[(4 * c4 + 3) * 72 + k] = f2bf(v[3]);
  }
  __syncthreads();
  const int n = tid >> 3, kc = tid & 7;
  *(u32x4*)(dst + (size_t)(n0 + n) * K + k0 + kc * 8) = *(const u32x4*)(t + n * 72 + kc * 8);
}

DI void phase_convert(const Params& P, int layer, char* smem, int tid) {
  char* W = P.ws + OFF_W;
  const int NU = layer == 0 ? 3072 : 3712;
  const int t1 = (NU / 32) * 16, t2 = t1 + 512, t3 = t2 + 4096, t4 = t3 + 2048, t5 = t4 + 128, t6 = t5 + 512, t7 = t6 + (layer == 0 ? 32 : 0);
  for (int t = blockIdx.x; t < t7; t += gridDim.x) {
    const float* src; int ld, col0, valid = 32, k0, K, n0; bf16_t* dst;
    if (t < t1) {
      const int nt = t >> 4, kt = t & 15; n0 = nt * 32; k0 = kt * 64; K = 1024; dst = (bf16_t*)(W + W_WIN);
      if (layer == 0) { src = P.ev_w_in; ld = 3072; col0 = n0; }
      else { src = P.od_w_in; ld = 3592;
        if (n0 < 1536) col0 = n0; else if (n0 < 3584) col0 = n0 + 8; else if (n0 == 3584) { col0 = 1536; valid = 8; } else { col0 = 0; valid = 0; } }
    } else if (t < t2) {
      const int q = t - t1, nt = q >> 4, kt = q & 15; n0 = nt * 32; k0 = kt * 64; K = 1024; dst = (bf16_t*)(W + W_WOUT);
      src = layer == 0 ? P.ev_w_out : P.od_w_out; ld = 1024; col0 = n0;
    } else if (t < t3) {
      const int q = t - t2, e = q >> 8, rt = (q >> 4) & 15, kt = q & 15; n0 = rt * 32; k0 = kt * 64; K = 1024;
      dst = (bf16_t*)(W + W_W13) + (size_t)e * 512 * 1024;
      src = ((rt & 1) ? P.moe_w3 : P.moe_w1) + (size_t)(layer * 16 + e) * 1024 * 256; ld = 256; col0 = (rt >> 1) * 32;
    } else if (t < t4) {
      const int q = t - t3, e = q >> 7, nt = (q >> 2) & 31, kt = q & 3; n0 = nt * 32; k0 = kt * 64; K = 256;
      dst = (bf16_t*)(W + W_W2) + (size_t)e * 1024 * 256;
      src = P.moe_w2 + (size_t)(layer * 16 + e) * 256 * 1024; ld = 1024; col0 = n0;
    } else if (t < t5) {
      const int q = t - t4, nt = q >> 2, kt = q & 3; n0 = nt * 32; k0 = kt * 64; K = 256; dst = (bf16_t*)(W + W_WP);
      src = P.ple_w_proj + (size_t)layer * 256 * 1024; ld = 1024; col0 = n0;
    } else if (t < t6) {
      const int q = t - t5, nt = q >> 4, kt = q & 15; n0 = nt * 32; k0 = kt * 64; K = 1024; dst = (bf16_t*)(W + W_WG);
      src = P.ple_w_gate + (size_t)layer * 1024 * 1024; ld = 1024; col0 = n0;
    } else {
      const int q = t - t6, which = q >> 4, hb = (q >> 1) & 7, nt = q & 1; n0 = nt * 32; k0 = 0; K = 64;
      dst = (bf16_t*)(W + (which ? W_WIT : W_WRT)) + hb * 4096;
      src = (which ? P.lru_w_i : P.lru_w_r) + hb * 4096; ld = 64; col0 = n0;
    }
    tr_tile(src, ld, col0, valid, k0, dst, K, n0, smem, tid);
  }
  const int gt = blockIdx.x * 256 + tid, gs = gridDim.x * 256;
  float* RW = (float*)(W + W_RW);
  for (int i = gt; i < 20480; i += gs) {
    const int e = i >> 10, k = i & 1023;
    float v;
    if (e < 4) v = P.moe_w_group[(size_t)(layer * 1024 + k) * 4 + e];
    else { const int g = (e - 4) >> 2, ee = (e - 4) & 3; v = P.moe_w_router[((size_t)(layer * 4 + g) * 1024 + k) * 4 + ee]; }
    RW[i] = v;
  }
  if (layer == 0) {
    bf16_t* hb = (bf16_t*)(P.ws + OFF_HB);
    for (int i = gt; i < T_TOK * DM / 4; i += gs) {
      const f32x4 v = *(const f32x4*)(P.x + (size_t)i * 4);
      u32x2 o; o.x = pack2(v[0], v[1]); o.y = pack2(v[2], v[3]);
      *(u32x2*)(hb + (size_t)i * 4) = o;
    }
    if (blockIdx.x == 0 && tid < 32) ((int*)(P.ws + OFF_SM + SM_CNT))[tid] = 0;
  }
}

DI void set_rows(const bf16_t* (&rp)[4], const bf16_t* base, int row0, int ld, int tid) {
#pragma unroll
  for (int i = 0; i < 4; ++i) rp[i] = base + (size_t)(row0 + (tid >> 3) + 32 * i) * ld + (tid & 7) * 8;
}

DI void phase_inproj(const Params& P, int layer, char* smem, int tid) {
  const int NT = layer == 0 ? 24 : 29, ldu = layer == 0 ? 3072 : 3584;
  const bf16_t* A = (const bf16_t*)(P.ws + OFF_HB);
  const bf16_t* Bt = (const bf16_t*)(P.ws + OFF_W + W_WIN);
  bf16_t* U = (bf16_t*)(P.ws + OFF_U);
  float* DT = (float*)(P.ws + OFF_SM + SM_DT);
  const int lane = tid & 63, w = tid >> 6, wm = w >> 1, wn = w & 1, h = lane >> 5;
  for (int t = blockIdx.x; t < 128 * NT; t += gridDim.x) {
    const int mt = t / NT, nt = t % NT;
    const bf16_t *ar[4], *br[4];
    set_rows(ar, A, mt * 128, 1024, tid); set_rows(br, Bt, nt * 128, 1024, tid);
    f32x16 acc[2][2]; acc[0][0] = acc[0][1] = acc[1][0] = acc[1][1] = zero16();
    gemm_mainloop(acc, ar, br, 1024, smem, tid);
#pragma unroll
    for (int mi = 0; mi < 2; ++mi)
#pragma unroll
      for (int ni = 0; ni < 2; ++ni)
#pragma unroll
        for (int r = 0; r < 16; ++r) {
          const int row = mt * 128 + wm * 64 + mi * 32 + crow(r, h), col = nt * 128 + wn * 64 + ni * 32 + (lane & 31);
          const float v = acc[mi][ni][r];
          if (layer == 1 && nt == 28) { if (col - 3584 < 8) DT[(size_t)row * 8 + col - 3584] = v; }
          else U[(size_t)row * ldu + col] = f2bf(v);
        }
  }
}

DI void phase_outproj(const Params& P, int layer, char* smem, int tid) {
  const bf16_t* A = (const bf16_t*)(P.ws + OFF_HB);
  const bf16_t* Bt = (const bf16_t*)(P.ws + OFF_W + W_WOUT);
  const float* hf = layer == 0 ? P.x : P.out;
  float* Y = (float*)(P.ws + OFF_Y);
  const int lane = tid & 63, w = tid >> 6, wm = w >> 1, wn = w & 1, h = lane >> 5;
  for (int t = blockIdx.x; t < 128 * 8; t += gridDim.x) {
    const int mt = t >> 3, nt = t & 7;
    const bf16_t *ar[4], *br[4];
    set_rows(ar, A, mt * 128, 1024, tid); set_rows(br, Bt, nt * 128, 1024, tid);
    f32x16 acc[2][2]; acc[0][0] = acc[0][1] = acc[1][0] = acc[1][1] = zero16();
    gemm_mainloop(acc, ar, br, 1024, smem, tid);
#pragma unroll
    for (int mi = 0; mi < 2; ++mi)
#pragma unroll
      for (int ni = 0; ni < 2; ++ni)
#pragma unroll
        for (int r = 0; r < 16; ++r) {
          const size_t idx = (size_t)(mt * 128 + wm * 64 + mi * 32 + crow(r, h)) * 1024 + nt * 128 + wn * 64 + ni * 32 + (lane & 31);
          Y[idx] = ALPHA * hf[idx] + acc[mi][ni][r];
        }
  }
}

DI void phase_ple(const Params& P, int layer, char* smem, int tid) {
  const bf16_t* A1 = (const bf16_t*)(P.ws + OFF_PB);
  const bf16_t* B1 = (const bf16_t*)(P.ws + OFF_W + W_WP);
  const bf16_t* A2 = (const bf16_t*)(P.ws + OFF_H1B);
  const bf16_t* B2 = (const bf16_t*)(P.ws + OFF_W + W_WG);
  const float* h2f = (const float*)(P.ws + OFF_Y);
  bf16_t* hb = (bf16_t*)(P.ws + OFF_HB);
  const int lane = tid & 63, w = tid >> 6, wm = w >> 1, wn = w & 1, h = lane >> 5;
  for (int t = blockIdx.x; t < 128 * 8; t += gridDim.x) {
    const int mt = t >> 3, nt = t & 7;
    const bf16_t *ar[4], *br[4];
    f32x16 acc[2][2];
    acc[0][0] = acc[0][1] = acc[1][0] = acc[1][1] = zero16();
    set_rows(ar, A2, mt * 128, 1024, tid); set_rows(br, B2, nt * 128, 1024, tid);
    gemm_mainloop(acc, ar, br, 1024, smem, tid);
    unsigned sg[2][2][8];
#pragma unroll
    for (int mi = 0; mi < 2; ++mi)
#pragma unroll
      for (int ni = 0; ni < 2; ++ni)
#pragma unroll
        for (int r = 0; r < 8; ++r) sg[mi][ni][r] = pack2(sigmoidf_(acc[mi][ni][2 * r]), sigmoidf_(acc[mi][ni][2 * r + 1]));
    acc[0][0] = acc[0][1] = acc[1][0] = acc[1][1] = zero16();
    set_rows(ar, A1, mt * 128, 256, tid); set_rows(br, B1, nt * 128, 256, tid);
    gemm_mainloop(acc, ar, br, 256, smem, tid);
#pragma unroll
    for (int mi = 0; mi < 2; ++mi)
#pragma unroll
      for (int ni = 0; ni < 2; ++ni)
#pragma unroll
        for (int r = 0; r < 16; ++r) {
          const size_t idx = (size_t)(mt * 128 + wm * 64 + mi * 32 + crow(r, h)) * 1024 + nt * 128 + wn * 64 + ni * 32 + (lane & 31);
          const unsigned pk = sg[mi][ni][r >> 1];
          const float sgm = (r & 1) ? __uint_as_float(pk & 0xffff0000u) : __uint_as_float(pk << 16);
          const float o = h2f[idx] + acc[mi][ni][r] * sgm;
          P.out[idx] = o;
          if (layer == 0) hb[idx] = f2bf(o);
        }
  }
}

DI bool moe_tile(const int* cnt, int t, int CT, int& e, int& rt, int& ct, int& n_e, int& hrow0) {
  int base = 0, rows = 0;
  for (int q = 0; q < 16; ++q) {
    const int n = cnt[q], nt = (n + 127) >> 7, ntl = nt * CT;
    if (t < base + ntl) { e = q; n_e = n; const int l = t - base; rt = l / CT; ct = l % CT; hrow0 = rows; return true; }
    base += ntl; rows += nt * 128;
  }
  return false;
}
DI int moe_total_tiles(const int* cnt, int CT) { int s = 0; for (int q = 0; q < 16; ++q) s += ((cnt[q] + 127) >> 7) * CT; return s; }

DI void phase_moe_up(const Params& P, int layer, char* smem, int tid) {
  const int* cnt = (const int*)(P.ws + OFF_SM + SM_CNT) + layer * 16;
  const int* list = (const int*)(P.ws + OFF_SM + SM_LIST);
  const bf16_t* A = (const bf16_t*)(P.ws + OFF_H1B);
  bf16_t* HB = (bf16_t*)(P.ws + OFF_HB);
  const int lane = tid & 63, w = tid >> 6, wm = w >> 1, wn = w & 1, h = lane >> 5;
  const int total = moe_total_tiles(cnt, 4);
  for (int t = blockIdx.x; t < total; t += gridDim.x) {
    int e, rt, ct, n_e, hrow0; moe_tile(cnt, t, 4, e, rt, ct, n_e, hrow0);
    const bf16_t* Bt = (const bf16_t*)(P.ws + OFF_W + W_W13) + (size_t)e * 512 * 1024;
    const bf16_t *ar[4], *br[4];
#pragma unroll
    for (int i = 0; i < 4; ++i) {
      int r = rt * 128 + (tid >> 3) + 32 * i; if (r >= n_e) r = 0;
      const int tok = list[e * 16384 + r] >> 1;
      ar[i] = A + (size_t)tok * 1024 + (tid & 7) * 8;
    }
    set_rows(br, Bt, ct * 128, 1024, tid);
    f32x16 acc[2][2]; acc[0][0] = acc[0][1] = acc[1][0] = acc[1][1] = zero16();
    gemm_mainloop(acc, ar, br, 1024, smem, tid);
#pragma unroll
    for (int mi = 0; mi < 2; ++mi)
#pragma unroll
      for (int r = 0; r < 16; ++r) {
        const int row = hrow0 + rt * 128 + wm * 64 + mi * 32 + crow(r, h);
        const int f = (ct * 2 + wn) * 32 + (lane & 31);
        HB[(size_t)row * 256 + f] = f2bf(siluf_(acc[mi][0][r]) * acc[mi][1][r]);
      }
  }
}

DI void phase_moe_down(const Params& P, int layer, char* smem, int tid) {
  const int* cnt = (const int*)(P.ws + OFF_SM + SM_CNT) + layer * 16;
  const int* list = (const int*)(P.ws + OFF_SM + SM_LIST);
  const float* gate = (const float*)(P.ws + OFF_SM + SM_GATE);
  const bf16_t* A = (const bf16_t*)(P.ws + OFF_HB);
  bf16_t* MO = (bf16_t*)P.out;
  const int lane = tid & 63, w = tid >> 6, wm = w >> 1, wn = w & 1, h = lane >> 5;
  const int total = moe_total_tiles(cnt, 8);
  for (int t = blockIdx.x; t < total; t += gridDim.x) {
    int e, rt, ct, n_e, hrow0; moe_tile(cnt, t, 8, e, rt, ct, n_e, hrow0);
    const bf16_t* Bt = (const bf16_t*)(P.ws + OFF_W + W_W2) + (size_t)e * 1024 * 256;
    const bf16_t *ar[4], *br[4];
    set_rows(ar, A, hrow0 + rt * 128, 256, tid); set_rows(br, Bt, ct * 128, 256, tid);
    f32x16 acc[2][2]; acc[0][0] = acc[0][1] = acc[1][0] = acc[1][1] = zero16();
    gemm_mainloop(acc, ar, br, 256, smem, tid);
#pragma unroll
    for (int mi = 0; mi < 2; ++mi)
#pragma unroll
      for (int r = 0; r < 16; ++r) {
        const int lr = rt * 128 + wm * 64 + mi * 32 + crow(r, h);
        if (lr < n_e) {
          const int entry = list[e * 16384 + lr];
          const float g = gate[entry];
#pragma unroll
          for (int ni = 0; ni < 2; ++ni)
            MO[(size_t)entry * 1024 + ct * 128 + wn * 64 + ni * 32 + (lane & 31)] = f2bf(g * acc[mi][ni][r]);
        }
      }
  }
}

DI void phase_ln_router(const Params& P, int layer, char* smem, int tid) {
  float* Y = (float*)(P.ws + OFF_Y);
  bf16_t* H1B = (bf16_t*)(P.ws + OFF_H1B);
  const float* RW = (const float*)(P.ws + OFF_W + W_RW);
  int* cnt = (int*)(P.ws + OFF_SM + SM_CNT) + layer * 16;
  int* list = (int*)(P.ws + OFF_SM + SM_LIST);
  float* gate = (float*)(P.ws + OFF_SM + SM_GATE);
  const float* lg = P.ln_mix_g + layer * 1024; const float* lb = P.ln_mix_b + layer * 1024;
  const float* bg = P.moe_b_group + layer * 4; const float* brt = P.moe_b_router + layer * 16;
  const int lane = tid & 63, w = tid >> 6;
  const int gw = blockIdx.x * 4 + w, nw = gridDim.x * 4;
#pragma unroll 1
  for (int row = gw; row < T_TOK; row += nw) {
    float xv[16];
#pragma unroll
    for (int i = 0; i < 4; ++i) {
      const f32x4 v = *(const f32x4*)(Y + (size_t)row * 1024 + 4 * lane + 256 * i);
      xv[4 * i] = v[0]; xv[4 * i + 1] = v[1]; xv[4 * i + 2] = v[2]; xv[4 * i + 3] = v[3];
    }
    float s = 0.f;
#pragma unroll
    for (int i = 0; i < 16; ++i) s += xv[i];
    const float mean = wave_sum(s) * (1.0f / 1024.0f);
    float q = 0.f;
#pragma unroll
    for (int i = 0; i < 16; ++i) { const float d = xv[i] - mean; q += d * d; }
    const float rstd = rsqrtf(wave_sum(q) * (1.0f / 1024.0f) + EPS);
#pragma unroll
    for (int i = 0; i < 4; ++i) {
      const f32x4 g4 = *(const f32x4*)(lg + 4 * lane + 256 * i), b4 = *(const f32x4*)(lb + 4 * lane + 256 * i);
      f32x4 o;
#pragma unroll
      for (int j = 0; j < 4; ++j) { o[j] = (xv[4 * i + j] - mean) * rstd * g4[j] + b4[j]; xv[4 * i + j] = o[j]; }
      *(f32x4*)(Y + (size_t)row * 1024 + 4 * lane + 256 * i) = o;
      u32x2 pk; pk.x = pack2(o[0], o[1]); pk.y = pack2(o[2], o[3]);
      *(u32x2*)(H1B + (size_t)row * 1024 + 4 * lane + 256 * i) = pk;
    }
    float* lg_s = (float*)smem + w * 32;
#pragma unroll 2
    for (int e = 0; e < 20; ++e) {
      float a0 = 0.f;
#pragma unroll
      for (int i = 0; i < 4; ++i) {
        const f32x4 wv = *(const f32x4*)(RW + e * 1024 + 4 * lane + 256 * i);
#pragma unroll
        for (int j = 0; j < 4; ++j) a0 += wv[j] * xv[4 * i + j];
      }
      a0 = wave_sum(a0);
      if (lane == 0) lg_s[e] = a0;
    }
    float lgt[20];
#pragma unroll
    for (int e = 0; e < 20; ++e) lgt[e] = lg_s[e];
    float gl[4];
#pragma unroll
    for (int g = 0; g < 4; ++g) gl[g] = lgt[g] + bg[g];
    int gs = 0; float gm = gl[0];
#pragma unroll
    for (int g = 1; g < 4; ++g) if (gl[g] > gm) { gm = gl[g]; gs = g; }
    float se = 0.f;
#pragma unroll
    for (int g = 0; g < 4; ++g) se += __expf(gl[g] - gm);
    const float pg = 1.0f / se;
    float el[4];
#pragma unroll
    for (int e = 0; e < 4; ++e) {
      float v = lgt[4 + e] + brt[e];
#pragma unroll
      for (int g = 1; g < 4; ++g) v = (gs == g) ? (lgt[4 + g * 4 + e] + brt[g * 4 + e]) : v;
      el[e] = v;
    }
    int i0 = 0; float v0 = el[0];
#pragma unroll
    for (int e = 1; e < 4; ++e) if (el[e] > v0) { v0 = el[e]; i0 = e; }
    int i1 = 0; float v1 = -3.0e38f;
#pragma unroll
    for (int e = 0; e < 4; ++e) if (e != i0 && el[e] > v1) { v1 = el[e]; i1 = e; }
    const float w0 = pg / (1.0f + __expf(v1 - v0)), w1 = pg - w0;
    if (lane == 0) {
      const int e0 = gs * 4 + i0, e1 = gs * 4 + i1;
      const int p0 = atomicAdd(&cnt[e0], 1); list[e0 * 16384 + p0] = row * 2; gate[row * 2] = w0;
      const int p1 = atomicAdd(&cnt[e1], 1); list[e1 * 16384 + p1] = row * 2 + 1; gate[row * 2 + 1] = w1;
    }
  }
  const int gt = blockIdx.x * 256 + tid, gs2 = gridDim.x * 256;
  bf16_t* PB = (bf16_t*)(P.ws + OFF_PB);
  const float* ps = P.p + (size_t)layer * T_TOK * 256;
  for (int i = gt; i < T_TOK * 256 / 4; i += gs2) {
    const f32x4 v = *(const f32x4*)(ps + (size_t)i * 4);
    u32x2 o; o.x = pack2(v[0], v[1]); o.y = pack2(v[2], v[3]);
    *(u32x2*)(PB + (size_t)i * 4) = o;
  }
}

DI void phase_ln2(const Params& P, int layer, char* smem, int tid) {
  float* Y = (float*)(P.ws + OFF_Y);
  bf16_t* H2B = (bf16_t*)(P.ws + OFF_H1B);
  const bf16_t* MO = (const bf16_t*)P.out;
  const float* lg = P.ln_ffn_g + layer * 1024; const float* lb = P.ln_ffn_b + layer * 1024;
  const int lane = tid & 63, w = tid >> 6;
  const int gw = blockIdx.x * 4 + w, nw = gridDim.x * 4;
  for (int row = gw; row < T_TOK; row += nw) {
    float xv[16];
#pragma unroll
    for (int i = 0; i < 4; ++i) {
      const f32x4 v = *(const f32x4*)(Y + (size_t)row * 1024 + 4 * lane + 256 * i);
      const u32x2 m0 = *(const u32x2*)(MO + (size_t)(row * 2) * 1024 + 4 * lane + 256 * i);
      const u32x2 m1 = *(const u32x2*)(MO + (size_t)(row * 2 + 1) * 1024 + 4 * lane + 256 * i);
      xv[4 * i + 0] = ALPHA * v[0] + (__uint_as_float(m0.x << 16) + __uint_as_float(m1.x << 16));
      xv[4 * i + 1] = ALPHA * v[1] + (__uint_as_float(m0.x & 0xffff0000u) + __uint_as_float(m1.x & 0xffff0000u));
      xv[4 * i + 2] = ALPHA * v[2] + (__uint_as_float(m0.y << 16) + __uint_as_float(m1.y << 16));
      xv[4 * i + 3] = ALPHA * v[3] + (__uint_as_float(m0.y & 0xffff0000u) + __uint_as_float(m1.y & 0xffff0000u));
    }
    float s = 0.f;
#pragma unroll
    for (int i = 0; i < 16; ++i) s += xv[i];
    const float mean = wave_sum(s) * (1.0f / 1024.0f);
    float q = 0.f;
#pragma unroll
    for (int i = 0; i < 16; ++i) { const float d = xv[i] - mean; q += d * d; }
    const float rstd = rsqrtf(wave_sum(q) * (1.0f / 1024.0f) + EPS);
#pragma unroll
    for (int i = 0; i < 4; ++i) {
      const f32x4 g4 = *(const f32x4*)(lg + 4 * lane + 256 * i), b4 = *(const f32x4*)(lb + 4 * lane + 256 * i);
      f32x4 o;
#pragma unroll
      for (int j = 0; j < 4; ++j) o[j] = (xv[4 * i + j] - mean) * rstd * g4[j] + b4[j];
      *(f32x4*)(Y + (size_t)row * 1024 + 4 * lane + 256 * i) = o;
      u32x2 pk; pk.x = pack2(o[0], o[1]); pk.y = pack2(o[2], o[3]);
      *(u32x2*)(H2B + (size_t)row * 1024 + 4 * lane + 256 * i) = pk;
    }
  }
}

DI void lru_tile(const Params& P, int mode, int b, int c, int kb, char* smem, int tid) {
  const int lane = tid & 63, w = tid >> 6, wm = w >> 1, wn = w & 1, h = lane >> 5;
  bf16_t* xcb = (bf16_t*)smem;
  bf16_t* wrs = xcb + 64 * 72;
  bf16_t* wis = wrs + 64 * 72;
  float* a_s = (float*)smem;
  float* u_s = (float*)(smem + 27648);
  float* xc_s = (float*)(smem + 27648 + 16384);
  float* seg_s = (float*)(smem + 27648 + 16384 + 16640);
  const bf16_t* U = (const bf16_t*)(P.ws + OFF_U);
  const int tok0 = b * SEQ + c * 64;
  __syncthreads();
  {
    const bf16_t* WRT = (const bf16_t*)(P.ws + OFF_W + W_WRT) + kb * 4096;
    const bf16_t* WIT = (const bf16_t*)(P.ws + OFF_W + W_WIT) + kb * 4096;
#pragma unroll
    for (int i = 0; i < 2; ++i) {
      const int ch = tid + 256 * i, row = ch >> 3, kc = ch & 7;
      *(u32x4*)(wrs + row * 72 + kc * 8) = *(const u32x4*)(WRT + row * 64 + kc * 8);
      *(u32x4*)(wis + row * 72 + kc * 8) = *(const u32x4*)(WIT + row * 64 + kc * 8);
    }
    const int j = tid >> 2, part = tid & 3, ch0 = kb * 64 + part * 16;
    float av[16];
#pragma unroll
    for (int q = 0; q < 16; ++q) av[q] = P.lru_conv_b[ch0 + q];
#pragma unroll
    for (int k = 0; k < 4; ++k) {
      const int jj = j - 3 + k;
      if (c > 0 || jj >= 0) {
        const bf16_t* src = U + (size_t)(tok0 + jj) * 3072 + ch0;
        float x0[8], x1[8];
        unpack8(*(const u32x4*)src, x0); unpack8(*(const u32x4*)(src + 8), x1);
#pragma unroll
        for (int q = 0; q < 8; ++q) { av[q] += P.lru_conv_w[k * 512 + ch0 + q] * x0[q]; av[8 + q] += P.lru_conv_w[k * 512 + ch0 + 8 + q] * x1[q]; }
      }
    }
#pragma unroll
    for (int q = 0; q < 16; ++q) xc_s[j * 65 + part * 16 + q] = av[q];
    float t0[8], t1[8];
#pragma unroll
    for (int q = 0; q < 8; ++q) { t0[q] = av[q]; t1[q] = av[8 + q]; }
    *(u32x4*)(xcb + j * 72 + part * 16) = pack8(t0);
    *(u32x4*)(xcb + j * 72 + part * 16 + 8) = pack8(t1);
  }
  __syncthreads();
  f32x16 ar[1][1], ai[1][1]; ar[0][0] = zero16(); ai[0][0] = zero16();
  wave_mma<1, 1, 64>(ar, xcb + wm * 32 * 72, 72, wrs + wn * 32 * 72, 72, lane);
  wave_mma<1, 1, 64>(ai, xcb + wm * 32 * 72, 72, wis + wn * 32 * 72, 72, lane);
  __syncthreads();
  {
    const int ch = wn * 32 + (lane & 31), cg = kb * 64 + ch;
    const float br = P.lru_b_r[cg], bi = P.lru_b_i[cg], sp = log1p_(__expf(-P.lru_lambda[cg]));
#pragma unroll
    for (int r = 0; r < 16; ++r) {
      const int t = wm * 32 + crow(r, h);
      const float rr = sigmoidf_(ar[0][0][r] + br), gi = sigmoidf_(ai[0][0][r] + bi);
      const float la = -8.0f * rr * sp;
      a_s[t * 64 + ch] = __expf(la);
      u_s[t * 64 + ch] = sqrtf(neg_expm1_(2.0f * la)) * gi * xc_s[t * 65 + ch];
    }
  }
  __syncthreads();
  const int seg = w, chn = lane, cg = kb * 64 + chn;
  float hl[16], pl[16];
  {
    float hh = 0.f, pp = 1.f;
#pragma unroll
    for (int i = 0; i < 16; ++i) {
      const int t = seg * 16 + i;
      const float a = a_s[t * 64 + chn], u = u_s[t * 64 + chn];
      pp *= a; hh = a * hh + u; hl[i] = hh; pl[i] = pp;
    }
    seg_s[seg * 64 + chn] = pp; seg_s[256 + seg * 64 + chn] = hh;
  }
  __syncthreads();
  float* sumA = (float*)(P.ws + OFF_SM + SM_SUMA);
  float* sumH = (float*)(P.ws + OFF_SM + SM_SUMH);
  if (mode == 0) {
    if (w == 0) {
      float A = 1.f, H = 0.f;
#pragma unroll
      for (int s = 0; s < 4; ++s) { const float a2 = seg_s[s * 64 + chn], h2 = seg_s[256 + s * 64 + chn]; H = a2 * H + h2; A *= a2; }
      sumA[(size_t)(b * NCH + c) * 512 + cg] = A; sumH[(size_t)(b * NCH + c) * 512 + cg] = H;
    }
  } else {
    float carry = 0.f;
    for (int c2 = 0; c2 < c; ++c2) carry = sumA[(size_t)(b * NCH + c2) * 512 + cg] * carry + sumH[(size_t)(b * NCH + c2) * 512 + cg];
    for (int s = 0; s < seg; ++s) carry = seg_s[s * 64 + chn] * carry + seg_s[256 + s * 64 + chn];
    bf16_t* MX = (bf16_t*)(P.ws + OFF_HB);
#pragma unroll
    for (int i = 0; i < 16; ++i) {
      const int t = seg * 16 + i;
      const float hv = hl[i] + pl[i] * carry;
      const float ya = bf2f(U[(size_t)(tok0 + t) * 3072 + 512 + cg]);
      MX[(size_t)(tok0 + t) * 1024 + cg] = f2bf(hv * geluf_(ya));
    }
  }
}

DI void store_tr8(bf16_t* img, int f0, int j, const float (&v)[8]) {
#pragma unroll
  for (int q = 0; q < 8; ++q) img[(f0 + q) * 72 + j] = f2bf(v[q]);
}
DI void load_slab128x64(bf16_t* img, const bf16_t* src, int src_ld, int tid) {
#pragma unroll
  for (int i = 0; i < 4; ++i) { const int ch = tid + 256 * i, row = ch >> 3, kc = ch & 7; *(u32x4*)(img + row * 72 + kc * 8) = *(const u32x4*)(src + (size_t)row * src_ld + kc * 8); }
}

DI float ret_lg2(int hd) { return log2f(1.0f - exp2f(-5.0f - (float)hd)); }

DI void ret1_tile(const Params& P, int b, int c, int hd, char* smem, int tid) {
  const int lane = tid & 63, w = tid >> 6, wm = w >> 1, wn = w & 1, h = lane >> 5;
  bf16_t* KT = (bf16_t*)smem;
  bf16_t* VT = KT + 128 * 72;
  const bf16_t* U = (const bf16_t*)(P.ws + OFF_U);
  __syncthreads();
  {
    const int j = tid >> 2, part = tid & 3, tok = b * SEQ + c * 64 + j;
    const float pos = (float)P.pos[tok];
    const float ks = 0.08838834764831845f * exp2f(ret_lg2(hd) * (float)(63 - j));
    const bf16_t* kr = U + (size_t)tok * 3072 + 1536 + hd * 128;
    const bf16_t* vr = U + (size_t)tok * 3072 + 2048 + hd * 128;
#pragma unroll
    for (int hh = 0; hh < 2; ++hh) {
      float k1[8], k2[8], o1[8], o2[8];
      unpack8(*(const u32x4*)(kr + part * 16 + hh * 8), k1); unpack8(*(const u32x4*)(kr + 64 + part * 16 + hh * 8), k2);
#pragma unroll
      for (int q = 0; q < 8; ++q) {
        const int d = part * 16 + hh * 8 + q;
        float sn, cs; sincos_rr(pos * exp2f(-(float)d * 0.20762050593046014f), sn, cs);
        o1[q] = (k1[q] * cs - k2[q] * sn) * ks; o2[q] = (k2[q] * cs + k1[q] * sn) * ks;
      }
      store_tr8(KT, part * 16 + hh * 8, j, o1); store_tr8(KT, 64 + part * 16 + hh * 8, j, o2);
    }
#pragma unroll
    for (int hh = 0; hh < 4; ++hh) { float v[8]; unpack8(*(const u32x4*)(vr + part * 32 + hh * 8), v); store_tr8(VT, part * 32 + hh * 8, j, v); }
  }
  __syncthreads();
  f32x16 acc[2][2]; acc[0][0] = acc[0][1] = acc[1][0] = acc[1][1] = zero16();
  wave_mma<2, 2, 64>(acc, VT + wm * 64 * 72, 72, KT + wn * 64 * 72, 72, lane);
  bf16_t* ST = (bf16_t*)(P.ws + OFF_ST) + (size_t)((b * NCH + c) * 4 + hd) * 16384;
#pragma unroll
  for (int mi = 0; mi < 2; ++mi)
#pragma unroll
    for (int ni = 0; ni < 2; ++ni)
#pragma unroll
      for (int r = 0; r < 16; ++r) ST[(wm * 64 + mi * 32 + crow(r, h)) * 128 + wn * 64 + ni * 32 + (lane & 31)] = f2bf(acc[mi][ni][r]);
}

DI void norm_gate_store(const f32x16 (&o)[2], bool center, const float* nw, const bf16_t* grow  , int ldu, bf16_t* mxrow  ,
                        int tok0, char* smem, int tid) {
  const int lane = tid & 63, w = tid >> 6, wm = w >> 1, wn = w & 1, h = lane >> 5;
  float* Os = (float*)smem;
  __syncthreads();
#pragma unroll
  for (int ni = 0; ni < 2; ++ni)
#pragma unroll
    for (int r = 0; r < 16; ++r) Os[(wm * 32 + crow(r, h)) * 132 + wn * 64 + ni * 32 + (lane & 31)] = o[ni][r];
  __syncthreads();
  const int row = tid >> 2, q = tid & 3;
  float v[32];
#pragma unroll
  for (int i = 0; i < 8; ++i) { const f32x4 t = *(const f32x4*)(Os + row * 132 + q * 32 + 4 * i); v[4 * i] = t[0]; v[4 * i + 1] = t[1]; v[4 * i + 2] = t[2]; v[4 * i + 3] = t[3]; }
  float mean = 0.f;
  if (center) {
    float s = 0.f;
#pragma unroll
    for (int i = 0; i < 32; ++i) s += v[i];
    s += __shfl_xor(s, 1); s += __shfl_xor(s, 2);
    mean = s * (1.0f / 128.0f);
  }
  float qq = 0.f;
#pragma unroll
  for (int i = 0; i < 32; ++i) { const float d = v[i] - mean; qq += d * d; }
  qq += __shfl_xor(qq, 1); qq += __shfl_xor(qq, 2);
  const float rstd = rsqrtf(qq * (1.0f / 128.0f) + EPS);
  const bf16_t* gp = grow + (size_t)(tok0 + row) * ldu + q * 32;
  bf16_t* op = mxrow + (size_t)(tok0 + row) * 1024 + q * 32;
#pragma unroll
  for (int i = 0; i < 4; ++i) {
    float g[8], ov[8];
    unpack8(*(const u32x4*)(gp + 8 * i), g);
#pragma unroll
    for (int j = 0; j < 8; ++j) ov[j] = (v[8 * i + j] - mean) * rstd * nw[q * 32 + 8 * i + j] * siluf_(g[j]);
    *(u32x4*)(op + 8 * i) = pack8(ov);
  }
}

DI void ret3_tile(const Params& P, int b, int c, int hd, char* smem, int tid) {
  const int lane = tid & 63, w = tid >> 6, wm = w >> 1, wn = w & 1, h = lane >> 5;
  bf16_t* Qs = (bf16_t*)smem;
  bf16_t* Ks = (bf16_t*)(smem + 17408);
  bf16_t* VT = (bf16_t*)(smem + 34816);
  bf16_t* Ss = (bf16_t*)(smem + 53248);
  bf16_t* Ps = (bf16_t*)(smem + 62464);
  const bf16_t* U = (const bf16_t*)(P.ws + OFF_U);
  const bf16_t* ST = (const bf16_t*)(P.ws + OFF_ST) + (size_t)((b * NCH + c) * 4 + hd) * 16384;
  const int tok0 = b * SEQ + c * 64;
  const float lg2 = ret_lg2(hd);
  __syncthreads();
  {
    const int j = tid >> 2, part = tid & 3, tok = tok0 + j;
    const float pos = (float)P.pos[tok];
    const bf16_t* qr = U + (size_t)tok * 3072 + 1024 + hd * 128;
    const bf16_t* kr = U + (size_t)tok * 3072 + 1536 + hd * 128;
    const bf16_t* vr = U + (size_t)tok * 3072 + 2048 + hd * 128;
#pragma unroll
    for (int hh = 0; hh < 2; ++hh) {
      float q1[8], q2[8], k1[8], k2[8], a1[8], a2[8], b1[8], b2[8];
      unpack8(*(const u32x4*)(qr + part * 16 + hh * 8), q1); unpack8(*(const u32x4*)(qr + 64 + part * 16 + hh * 8), q2);
      unpack8(*(const u32x4*)(kr + part * 16 + hh * 8), k1); unpack8(*(const u32x4*)(kr + 64 + part * 16 + hh * 8), k2);
#pragma unroll
      for (int q = 0; q < 8; ++q) {
        const int d = part * 16 + hh * 8 + q;
        float sn, cs; sincos_rr(pos * exp2f(-(float)d * 0.20762050593046014f), sn, cs);
        a1[q] = q1[q] * cs - q2[q] * sn; a2[q] = q2[q] * cs + q1[q] * sn;
        b1[q] = (k1[q] * cs - k2[q] * sn) * 0.08838834764831845f; b2[q] = (k2[q] * cs + k1[q] * sn) * 0.08838834764831845f;
      }
      *(u32x4*)(Qs + j * 136 + part * 16 + hh * 8) = pack8(a1); *(u32x4*)(Qs + j * 136 + 64 + part * 16 + hh * 8) = pack8(a2);
      *(u32x4*)(Ks + j * 136 + part * 16 + hh * 8) = pack8(b1); *(u32x4*)(Ks + j * 136 + 64 + part * 16 + hh * 8) = pack8(b2);
    }
#pragma unroll
    for (int hh = 0; hh < 4; ++hh) { float v[8]; unpack8(*(const u32x4*)(vr + part * 32 + hh * 8), v); store_tr8(VT, part * 32 + hh * 8, j, v); }
    load_slab128x64(Ps, ST, 128, tid);
  }
  __syncthreads();
  f32x16 oin[1][2], oit[1][2]; oin[0][0] = oin[0][1] = oit[0][0] = oit[0][1] = zero16();
  {
    f32x16 s[1][1]; s[0][0] = zero16();
    wave_mma<1, 1, 128>(s, Qs + wm * 32 * 136, 136, Ks + wn * 32 * 136, 136, lane);
#pragma unroll
    for (int r = 0; r < 16; ++r) {
      const int i = wm * 32 + crow(r, h), jj = wn * 32 + (lane & 31);
      const int dd = i > jj ? i - jj : jj - i;
      Ss[i * 72 + jj] = f2bf(s[0][0][r] * exp2f(lg2 * (float)dd));
    }
    wave_mma<1, 2, 64>(oit, Qs + wm * 32 * 136, 136, Ps + wn * 64 * 72, 72, lane);
  }
  __syncthreads();
  load_slab128x64(Ps, ST + 64, 128, tid);
  wave_mma<1, 2, 64>(oin, Ss + wm * 32 * 72, 72, VT + wn * 64 * 72, 72, lane);
  __syncthreads();
  wave_mma<1, 2, 64>(oit, Qs + wm * 32 * 136 + 64, 136, Ps + wn * 64 * 72, 72, lane);
  f32x16 o[2];
#pragma unroll
  for (int ni = 0; ni < 2; ++ni)
#pragma unroll
    for (int r = 0; r < 16; ++r) { const int i = wm * 32 + crow(r, h); o[ni][r] = oin[0][ni][r] + exp2f(lg2 * (float)(i + 1)) * oit[0][ni][r]; }
  norm_gate_store(o, true, P.ret_gn_w + hd * 128, U + 2560 + hd * 128, 3072, (bf16_t*)(P.ws + OFF_HB) + 512 + hd * 128, tok0, smem, tid);
}

template <int MODE>
DI void scan_item(const Params& P, int item) {
  bf16_t* base; size_t cstride; float dconst = 0.f; const float* dptr = nullptr; size_t dstride = 0;
  if (MODE == 0) { const int x4 = item & 4095, bh = item >> 12, b = bh >> 2, hd = bh & 3;
    base = (bf16_t*)(P.ws + OFF_ST) + (size_t)(b * NCH * 4 + hd) * 16384 + x4 * 4; cstride = 4 * 16384; dconst = exp2f(ret_lg2(hd) * 64.0f); }
  else if (MODE == 1) { const int x4 = item & 2047, bh = item >> 11, b = bh >> 3, hh = bh & 7;
    base = (bf16_t*)(P.ws + OFF_ST) + (size_t)(b * NCH * 8 + hh) * 8192 + x4 * 4; cstride = 8 * 8192;
    dptr = (const float*)(P.ws + OFF_SM + SM_CD) + b * NCH * 8 + hh; dstride = 8; }
  else { const int x4 = item & 4095, bh = item >> 12, b = bh >> 2, hd = bh & 3;
    base = (bf16_t*)(P.ws + OFF_ST + 32 * MiB) + (size_t)(b * NCH * 4 + hd) * 16384 + x4 * 4; cstride = 4 * 16384;
    dptr = (const float*)(P.ws + OFF_SM + SM_HD) + (size_t)(b * NCH * 4 + hd) * 128 + ((x4 * 4) & 127); dstride = 4 * 128; }
  float run[4] = {0.f, 0.f, 0.f, 0.f};
  for (int c0 = 0; c0 < NCH; c0 += 8) {
    u32x2 loc[8]; f32x4 dv[8];
#pragma unroll
    for (int i = 0; i < 8; ++i) {
      loc[i] = *(const u32x2*)(base + (size_t)(c0 + i) * cstride);
      if (MODE == 1) { const float d = dptr[(size_t)(c0 + i) * dstride]; dv[i] = (f32x4){d, d, d, d}; }
      else if (MODE == 2) dv[i] = *(const f32x4*)(dptr + (size_t)(c0 + i) * dstride);
      else dv[i] = (f32x4){dconst, dconst, dconst, dconst};
    }
#pragma unroll
    for (int i = 0; i < 8; ++i) {
      u32x2 o; o.x = pack2(run[0], run[1]); o.y = pack2(run[2], run[3]);
      *(u32x2*)(base + (size_t)(c0 + i) * cstride) = o;
      run[0] = dv[i][0] * run[0] + __uint_as_float(loc[i].x << 16);
      run[1] = dv[i][1] * run[1] + __uint_as_float(loc[i].x & 0xffff0000u);
      run[2] = dv[i][2] * run[2] + __uint_as_float(loc[i].y << 16);
      run[3] = dv[i][3] * run[3] + __uint_as_float(loc[i].y & 0xffff0000u);
    }
  }
}

DI void conv_silu8(const Params& P, const bf16_t* U, int tok0, int j, int c, int xc0, float (&o)[8]) {
#pragma unroll
  for (int q = 0; q < 8; ++q) o[q] = P.ssd_conv_b[xc0 + q];
#pragma unroll
  for (int k = 0; k < 4; ++k) {
    const int jj = j - 3 + k;
    if (c > 0 || jj >= 0) {
      float x[8]; unpack8(*(const u32x4*)(U + (size_t)(tok0 + jj) * 3584 + 512 + xc0), x);
#pragma unroll
      for (int q = 0; q < 8; ++q) o[q] += P.ssd_conv_w[k * 1024 + xc0 + q] * x[q];
    }
  }
#pragma unroll
  for (int q = 0; q < 8; ++q) o[q] = siluf_(o[q]);
}

DI void ssd_dt(const Params& P, int b, int c, int g, float* dt_s, float* cs_s, int tid) {
  const int lane = tid & 63, hh = tid >> 6, hd = g * 4 + hh;
  const float* DT = (const float*)(P.ws + OFF_SM + SM_DT);
  const int tok = b * SEQ + c * 64 + lane;
  const float dt = softplusf_(DT[(size_t)tok * 8 + hd] + P.ssd_dt_bias[hd]);
  const float a = -__expf(P.ssd_a_log[hd]);
  float v = dt * a;
#pragma unroll
  for (int o = 1; o < 64; o <<= 1) { const float t = __shfl_up(v, o); if (lane >= o) v += t; }
  dt_s[hh * 64 + lane] = dt; cs_s[hh * 64 + lane] = v;
}

DI void ssd1_tile(const Params& P, int b, int c, int g, char* smem, int tid) {
  const int lane = tid & 63, w = tid >> 6, wm = w >> 1, wn = w & 1, h = lane >> 5;
  bf16_t* BT = (bf16_t*)smem;
  bf16_t* XT = (bf16_t*)(smem + 18432);
  float* dt_s = (float*)(smem + 18432 + 36864);
  float* cs_s = dt_s + 256;
  const bf16_t* U = (const bf16_t*)(P.ws + OFF_U);
  const int tok0 = b * SEQ + c * 64;
  __syncthreads();
  ssd_dt(P, b, c, g, dt_s, cs_s, tid);
  __syncthreads();
  {
    const int j = tid >> 2, part = tid & 3;
    const float wgt = dt_s[part * 64 + j] * __expf(cs_s[part * 64 + 63] - cs_s[part * 64 + j]);
#pragma unroll
    for (int blk = 0; blk < 8; ++blk) {
      float o[8]; conv_silu8(P, U, tok0, j, c, 256 * g + 64 * part + 8 * blk, o);
#pragma unroll
      for (int q = 0; q < 8; ++q) o[q] *= wgt;
      store_tr8(XT + part * 64 * 72, 8 * blk, j, o);
    }
#pragma unroll
    for (int blk = 0; blk < 4; ++blk) {
      float o[8]; conv_silu8(P, U, tok0, j, c, 512 + 128 * g + 32 * part + 8 * blk, o);
      store_tr8(BT, 32 * part + 8 * blk, j, o);
    }
    if (tid < 4) ((float*)(P.ws + OFF_SM + SM_CD))[(b * NCH + c) * 8 + g * 4 + tid] = __expf(cs_s[tid * 64 + 63]);
  }
  __syncthreads();
#pragma unroll 1
  for (int hh = 0; hh < 4; ++hh) {
    f32x16 acc[1][2]; acc[0][0] = acc[0][1] = zero16();
    wave_mma<1, 2, 64>(acc, XT + hh * 64 * 72 + wm * 32 * 72, 72, BT + wn * 64 * 72, 72, lane);
    bf16_t* ST = (bf16_t*)(P.ws + OFF_ST) + (size_t)((b * NCH + c) * 8 + g * 4 + hh) * 8192;
#pragma unroll
    for (int ni = 0; ni < 2; ++ni)
#pragma unroll
      for (int r = 0; r < 16; ++r) ST[(wm * 32 + crow(r, h)) * 128 + wn * 64 + ni * 32 + (lane & 31)] = f2bf(acc[0][ni][r]);
  }
}

DI void ssd3_tile(const Params& P, int b, int c, int g, char* smem, int tid) {
  const int lane = tid & 63, w = tid >> 6, wm = w >> 1, wn = w & 1, h = lane >> 5;
  bf16_t* Cs = (bf16_t*)smem;
  bf16_t* Bs = (bf16_t*)(smem + 17408);
  bf16_t* Ps = (bf16_t*)(smem + 34816);
  bf16_t* XT = (bf16_t*)(smem + 52224);
  bf16_t* Ss = (bf16_t*)(smem + 61440);
  float* dt_s = (float*)(smem + 70656);
  float* cs_s = dt_s + 256;
  float* ssq_s = cs_s + 256;
  const bf16_t* U = (const bf16_t*)(P.ws + OFF_U);
  const int tok0 = b * SEQ + c * 64;
  __syncthreads();
  ssd_dt(P, b, c, g, dt_s, cs_s, tid);
  {
    const int j = tid >> 2, part = tid & 3;
#pragma unroll 1
    for (int blk = 0; blk < 4; ++blk) {
      float o[8]; conv_silu8(P, U, tok0, j, c, 512 + 128 * g + 32 * part + 8 * blk, o);
      *(u32x4*)(Bs + j * 136 + 32 * part + 8 * blk) = pack8(o);
      conv_silu8(P, U, tok0, j, c, 768 + 128 * g + 32 * part + 8 * blk, o);
      *(u32x4*)(Cs + j * 136 + 32 * part + 8 * blk) = pack8(o);
    }
  }
  __syncthreads();
  f32x16 G[1][1]; G[0][0] = zero16();
  wave_mma<1, 1, 128>(G, Cs + wm * 32 * 136, 136, Bs + wn * 32 * 136, 136, lane);
  f32x16 yv0 = zero16(), yv1 = zero16(), yv2 = zero16(), yv3 = zero16();
  float ssq[16];
#pragma unroll
  for (int r = 0; r < 16; ++r) ssq[r] = 0.f;
#pragma unroll 1
  for (int hh = 0; hh < 4; ++hh) {
    const int hd = g * 4 + hh;
    if (hh > 0) __syncthreads();
    {
      const int j = tid >> 2, part = tid & 3;
#pragma unroll 1
      for (int blk = 0; blk < 2; ++blk) {
        float o[8]; conv_silu8(P, U, tok0, j, c, 64 * hd + 16 * part + 8 * blk, o);
        store_tr8(XT, 16 * part + 8 * blk, j, o);
      }
      const bf16_t* ST = (const bf16_t*)(P.ws + OFF_ST) + (size_t)((b * NCH + c) * 8 + hd) * 8192;
#pragma unroll
      for (int i = 0; i < 4; ++i) { const int ch = tid + 256 * i, row = ch >> 4, kc = ch & 15; *(u32x4*)(Ps + row * 136 + kc * 8) = *(const u32x4*)(ST + row * 128 + kc * 8); }
#pragma unroll
      for (int r = 0; r < 16; ++r) {
        const int i = wm * 32 + crow(r, h), jj = wn * 32 + (lane & 31);
        const float l = (i >= jj) ? __expf(cs_s[hh * 64 + i] - cs_s[hh * 64 + jj]) * dt_s[hh * 64 + jj] : 0.f;
        Ss[i * 72 + jj] = f2bf(G[0][0][r] * l);
      }
    }
    __syncthreads();
    f32x16 yi[1][1], ye[1][1]; yi[0][0] = zero16(); ye[0][0] = zero16();
    wave_mma<1, 1, 64>(yi, Ss + wm * 32 * 72, 72, XT + wn * 32 * 72, 72, lane);
    wave_mma<1, 1, 128>(ye, Cs + wm * 32 * 136, 136, Ps + wn * 32 * 136, 136, lane);
    const float dsk = P.ssd_d[hd];
    yv3 = yv2; yv2 = yv1; yv1 = yv0;
#pragma unroll
    for (int r = 0; r < 16; ++r) {
      const int i = wm * 32 + crow(r, h), pp = wn * 32 + (lane & 31);
      float y = yi[0][0][r] + __expf(cs_s[hh * 64 + i]) * ye[0][0][r] + bf2f(XT[pp * 72 + i]) * dsk;
      const float z = bf2f(U[(size_t)(tok0 + i) * 3584 + 64 * hd + pp]);
      y *= siluf_(z);
      yv0[r] = y; ssq[r] += y * y;
    }
  }
#pragma unroll
  for (int r = 0; r < 16; ++r) {
    float s = ssq[r];
#pragma unroll
    for (int o = 16; o >= 1; o >>= 1) s += __shfl_xor(s, o);
    if ((lane & 31) == 0) ssq_s[(wm * 32 + crow(r, h)) * 2 + wn] = s;
  }
  __syncthreads();
  bf16_t* MX = (bf16_t*)(P.ws + OFF_HB);
#pragma unroll
  for (int r = 0; r < 16; ++r) {
    const int i = wm * 32 + crow(r, h), pp = wn * 32 + (lane & 31);
    const float rstd = rsqrtf((ssq_s[i * 2] + ssq_s[i * 2 + 1]) * (1.0f / 256.0f) + EPS);
    const int ch = 64 * (g * 4) + pp;
    bf16_t* mp = MX + (size_t)(tok0 + i) * 1024 + ch;
    mp[0] = f2bf(yv3[r] * rstd * P.ssd_norm_w[ch]);
    mp[64] = f2bf(yv2[r] * rstd * P.ssd_norm_w[ch + 64]);
    mp[128] = f2bf(yv1[r] * rstd * P.ssd_norm_w[ch + 128]);
    mp[192] = f2bf(yv0[r] * rstd * P.ssd_norm_w[ch + 192]);
  }
}

DI void hgrn_logf_cumsum(const Params& P, const bf16_t* U, int tok0, int hd, float* bs, int tid) {
  {
    const int j = tid >> 2, part = tid & 3;
    const bf16_t* fr = U + (size_t)(tok0 + j) * 3584 + 2048 + hd * 128 + part * 32;
#pragma unroll
    for (int blk = 0; blk < 4; ++blk) {
      float x[8]; unpack8(*(const u32x4*)(fr + 8 * blk), x);
#pragma unroll
      for (int q = 0; q < 8; ++q) {
        const int ch = hd * 128 + part * 32 + 8 * blk + q;
        const float lbv = 1.0f / (1.0f + __expf(P.lb_logits[ch] - P.lb_logits[512 + ch]));
        const float f = lbv + (1.0f - lbv) * sigmoidf_(x[q]);
        bs[j * 128 + part * 32 + 8 * blk + q] = __logf(f);
      }
    }
  }
  __syncthreads();
  {
    const int k = tid & 127, half = tid >> 7;
    float run = 0.f;
#pragma unroll
    for (int i = 0; i < 32; ++i) { const int j = half * 32 + i; run += bs[j * 128 + k]; bs[j * 128 + k] = run; }
  }
  __syncthreads();
  {
    const int k = tid & 127, half = tid >> 7;
    if (half == 1) { const float add = bs[31 * 128 + k];
#pragma unroll
      for (int i = 0; i < 32; ++i) bs[(32 + i) * 128 + k] += add; }
  }
  __syncthreads();
}

DI void hgrn1_tile(const Params& P, int b, int c, int hd, char* smem, int tid) {
  const int lane = tid & 63, w = tid >> 6, wm = w >> 1, wn = w & 1, h = lane >> 5;
  float* bs = (float*)smem;
  bf16_t* KT = (bf16_t*)(smem + 32768);
  bf16_t* VT = (bf16_t*)(smem + 32768 + 18432);
  const bf16_t* U = (const bf16_t*)(P.ws + OFF_U);
  const int tok0 = b * SEQ + c * 64;
  __syncthreads();
  hgrn_logf_cumsum(P, U, tok0, hd, bs, tid);
  {
    const int j = tid >> 2, part = tid & 3;
    const bf16_t* vr = U + (size_t)(tok0 + j) * 3584 + 2560 + hd * 128 + part * 32;
#pragma unroll
    for (int blk = 0; blk < 4; ++blk) {
      float v[8]; unpack8(*(const u32x4*)(vr + 8 * blk), v); store_tr8(VT, part * 32 + 8 * blk, j, v);
      float kd[8];
#pragma unroll
      for (int q = 0; q < 8; ++q) {
        const int k = part * 32 + 8 * blk + q;
        const float bj = bs[j * 128 + k], bp = j > 0 ? bs[(j - 1) * 128 + k] : 0.f, be = bs[63 * 128 + k];
        kd[q] = (1.0f - __expf(bj - bp)) * __expf(be - bj);
      }
      store_tr8(KT, part * 32 + 8 * blk, j, kd);
    }
    if (tid < 128) ((float*)(P.ws + OFF_SM + SM_HD))[(size_t)((b * NCH + c) * 4 + hd) * 128 + tid] = __expf(bs[63 * 128 + tid]);
  }
  __syncthreads();
  f32x16 acc[2][2]; acc[0][0] = acc[0][1] = acc[1][0] = acc[1][1] = zero16();
  wave_mma<2, 2, 64>(acc, VT + wm * 64 * 72, 72, KT + wn * 64 * 72, 72, lane);
  bf16_t* ST = (bf16_t*)(P.ws + OFF_ST + 32 * MiB) + (size_t)((b * NCH + c) * 4 + hd) * 16384;
#pragma unroll
  for (int mi = 0; mi < 2; ++mi)
#pragma unroll
    for (int ni = 0; ni < 2; ++ni)
#pragma unroll
      for (int r = 0; r < 16; ++r) ST[(wm * 64 + mi * 32 + crow(r, h)) * 128 + wn * 64 + ni * 32 + (lane & 31)] = f2bf(acc[mi][ni][r]);
}

DI void hgrn3_tile(const Params& P, int b, int c, int hd, char* smem, int tid) {
  const int lane = tid & 63, w = tid >> 6, wm = w >> 1, wn = w & 1, h = lane >> 5;
  float* bs = (float*)smem;
  bf16_t* VT = (bf16_t*)smem;
  bf16_t* Ss = (bf16_t*)(smem + 18432);
  bf16_t* Qd = (bf16_t*)(smem + 32768);
  bf16_t* Kd = (bf16_t*)(smem + 32768 + 17408);
  bf16_t* Ps = Kd;
  const bf16_t* U = (const bf16_t*)(P.ws + OFF_U);
  const bf16_t* ST = (const bf16_t*)(P.ws + OFF_ST + 32 * MiB) + (size_t)((b * NCH + c) * 4 + hd) * 16384;
  const int tok0 = b * SEQ + c * 64;
  __syncthreads();
  hgrn_logf_cumsum(P, U, tok0, hd, bs, tid);
  {
    const int j = tid >> 2, part = tid & 3;
    const bf16_t* qr = U + (size_t)(tok0 + j) * 3584 + 1536 + hd * 128 + part * 32;
#pragma unroll
    for (int blk = 0; blk < 4; ++blk) {
      float x[8], qd[8], kd[8]; unpack8(*(const u32x4*)(qr + 8 * blk), x);
#pragma unroll
      for (int q = 0; q < 8; ++q) {
        const int k = part * 32 + 8 * blk + q;
        const float bj = bs[j * 128 + k], bp = j > 0 ? bs[(j - 1) * 128 + k] : 0.f, rf = bs[31 * 128 + k];
        qd[q] = siluf_(x[q]) * __expf(bj - rf);
        kd[q] = (1.0f - __expf(bj - bp)) * __expf(rf - bj);
      }
      *(u32x4*)(Qd + j * 136 + part * 32 + 8 * blk) = pack8(qd);
      *(u32x4*)(Kd + j * 136 + part * 32 + 8 * blk) = pack8(kd);
    }
  }
  float erv[2][8];
#pragma unroll
  for (int hf = 0; hf < 2; ++hf)
#pragma unroll
    for (int q = 0; q < 8; ++q) erv[hf][q] = __expf(bs[31 * 128 + hf * 64 + (tid & 7) * 8 + q]);
  __syncthreads();
  {
    const int j = tid >> 2, part = tid & 3;
    const bf16_t* vr = U + (size_t)(tok0 + j) * 3584 + 2560 + hd * 128 + part * 32;
#pragma unroll
    for (int blk = 0; blk < 4; ++blk) { float v[8]; unpack8(*(const u32x4*)(vr + 8 * blk), v); store_tr8(VT, part * 32 + 8 * blk, j, v); }
  }
  {
    f32x16 s[1][1]; s[0][0] = zero16();
    wave_mma<1, 1, 128>(s, Qd + wm * 32 * 136, 136, Kd + wn * 32 * 136, 136, lane);
#pragma unroll
    for (int r = 0; r < 16; ++r) {
      const int i = wm * 32 + crow(r, h), jj = wn * 32 + (lane & 31);
      Ss[i * 72 + jj] = f2bf(i >= jj ? s[0][0][r] : 0.f);
    }
  }
  __syncthreads();
  f32x16 oin[1][2], oit[1][2]; oin[0][0] = oin[0][1] = oit[0][0] = oit[0][1] = zero16();
#pragma unroll
  for (int hf = 0; hf < 2; ++hf) {
    if (hf == 1) __syncthreads();
#pragma unroll
    for (int i = 0; i < 4; ++i) {
      const int ch = tid + 256 * i, row = ch >> 3, kc = ch & 7;
      float x[8]; unpack8(*(const u32x4*)(ST + (size_t)row * 128 + hf * 64 + kc * 8), x);
#pragma unroll
      for (int q = 0; q < 8; ++q) x[q] *= erv[hf][q];
      *(u32x4*)(Ps + row * 72 + kc * 8) = pack8(x);
    }
    if (hf == 0) wave_mma<1, 2, 64>(oin, Ss + wm * 32 * 72, 72, VT + wn * 64 * 72, 72, lane);
    __syncthreads();
    wave_mma<1, 2, 64>(oit, Qd + wm * 32 * 136 + hf * 64, 136, Ps + wn * 64 * 72, 72, lane);
  }
  f32x16 o[2];
#pragma unroll
  for (int ni = 0; ni < 2; ++ni)
#pragma unroll
    for (int r = 0; r < 16; ++r) o[ni][r] = oin[0][ni][r] + oit[0][ni][r];
  norm_gate_store(o, false, P.hgrn_norm_w + hd * 128, U + 3072 + hd * 128, 3584, (bf16_t*)(P.ws + OFF_HB) + 512 + hd * 128, tok0, smem, tid);
}

#define OPAQUE_TID(tt) int tt; asm volatile("v_mbcnt_lo_u32_b32 %0, -1, 0\n\tv_mbcnt_hi_u32_b32 %0, -1, %0" : "=v"(tt)); tt |= __builtin_amdgcn_readfirstlane(tid) & ~63
DI void phase_mix1(const Params& P, int layer, char* smem, int tid) {
  if (layer == 0) {
#pragma unroll 1
    for (int t = blockIdx.x; t < 1024; t += gridDim.x) { OPAQUE_TID(tt); ret1_tile(P, t >> 7, (t >> 2) & 31, t & 3, smem, tt); }
#pragma unroll 1
    for (int q = blockIdx.x; q < 2048; q += gridDim.x) { OPAQUE_TID(tt); lru_tile(P, 0, q >> 8, (q >> 3) & 31, q & 7, smem, tt); }
  } else {
#pragma unroll 1
    for (int t = blockIdx.x; t < 1024; t += gridDim.x) { OPAQUE_TID(tt); hgrn1_tile(P, t >> 7, (t >> 2) & 31, t & 3, smem, tt); }
#pragma unroll 1
    for (int q = blockIdx.x; q < 512; q += gridDim.x) { OPAQUE_TID(tt); ssd1_tile(P, q >> 6, (q >> 1) & 31, q & 1, smem, tt); }
  }
}
DI void phase_mix2(const Params& P, int layer, int tid) {
  const int gt = blockIdx.x * 256 + tid, gs = gridDim.x * 256;
  if (layer == 0) { for (int i = gt; i < 131072; i += gs) scan_item<0>(P, i); }
  else { for (int i = gt; i < 262144; i += gs) { if (i < 131072) scan_item<1>(P, i); else scan_item<2>(P, i - 131072); } }
}
DI void phase_mix3(const Params& P, int layer, char* smem, int tid) {
  if (layer == 0) {
#pragma unroll 1
    for (int t = blockIdx.x; t < 1024; t += gridDim.x) { OPAQUE_TID(tt); ret3_tile(P, t >> 7, (t >> 2) & 31, t & 3, smem, tt); }
#pragma unroll 1
    for (int q = blockIdx.x; q < 2048; q += gridDim.x) { OPAQUE_TID(tt); lru_tile(P, 1, q >> 8, (q >> 3) & 31, q & 7, smem, tt); }
  } else {
#pragma unroll 1
    for (int t = blockIdx.x; t < 1024; t += gridDim.x) { OPAQUE_TID(tt); hgrn3_tile(P, t >> 7, (t >> 2) & 31, t & 3, smem, tt); }
#pragma unroll 1
    for (int q = blockIdx.x; q < 512; q += gridDim.x) { OPAQUE_TID(tt); ssd3_tile(P, q >> 6, (q >> 1) & 31, q & 1, smem, tt); }
  }
}

#define XB_TMO      128
#define XB_XCNT(j)  (256  + 64 * (j))
#define XB_XSUB(j)  (1280 + 64 * (j))
#define XB_XGEN(j)  (2304 + 64 * (j))
#define XB_TOP      3328
#define XB_TOPGEN   3392
#define XCD_BAR_WORDS 3456
#define XB_SPIN_CAP (1u << 22)
DI unsigned xb_ld(unsigned* p) { return __hip_atomic_load(p, __ATOMIC_RELAXED, __HIP_MEMORY_SCOPE_AGENT); }
DI unsigned xb_add(unsigned* p, unsigned v) { return __hip_atomic_fetch_add(p, v, __ATOMIC_RELAXED, __HIP_MEMORY_SCOPE_AGENT); }
DI unsigned xb_xcc_id() { return (unsigned)__builtin_amdgcn_s_getreg((3 << 11) | 20) & 0xFu; }
#define XB_SPIN(cond, bar) do { unsigned _sp = 0; while (cond) { __builtin_amdgcn_s_sleep(1); \
    if ((++_sp & 255u) == 0u) { if (xb_ld(&(bar)[XB_TMO])) break; if (_sp > XB_SPIN_CAP) { atomicAdd(&(bar)[XB_TMO], 1u); break; } } } } while (0)
DI void xb_complete(unsigned* bar, unsigned x, unsigned& nloc, unsigned& nx) {
  const unsigned G = gridDim.x;
  unsigned sum, cnt, mine, sp = 0u;
  for (;;) {
    sum = 0u; cnt = 0u; mine = 0u;
#pragma unroll
    for (unsigned j = 0; j < 16; ++j) { const unsigned c = xb_ld(&bar[XB_XCNT(j)]); sum += c; cnt += (c > 0u) ? 1u : 0u; mine = (j == x) ? c : mine; }
    if (sum == G) break;
    __builtin_amdgcn_s_sleep(1);
    if ((++sp & 255u) == 0u) { if (xb_ld(&bar[XB_TMO])) break; if (sp > XB_SPIN_CAP) { atomicAdd(&bar[XB_TMO], 1u); break; } }
  }
  nloc = mine > 0u ? mine : 1u; nx = cnt > 0u ? cnt : 1u;
}
DI void grid_barrier(unsigned* bar, volatile unsigned* st, int tid) {
  asm volatile("s_waitcnt vmcnt(0)" ::: "memory");
  __syncthreads();
  if (tid == 0) {
    __builtin_amdgcn_s_waitcnt(0);
    const unsigned x = xb_xcc_id();
    unsigned nloc = st[0], nx = st[1];
    if (nloc == 0u) { xb_complete(bar, x, nloc, nx); st[0] = nloc; st[1] = nx; }
    const unsigned old = xb_add(&bar[XB_XSUB(x)], 1u);
    const unsigned gen = old / nloc;
    if (old + 1u == (gen + 1u) * nloc) {
      __builtin_amdgcn_fence(__ATOMIC_RELEASE, "agent");
      asm volatile("s_waitcnt vmcnt(0)" ::: "memory");
      const unsigned og = xb_add(&bar[XB_TOP], 1u);
      const unsigned tg = og / nx;
      if (og + 1u == (tg + 1u) * nx) xb_add(&bar[XB_TOPGEN], 1u);
      else XB_SPIN(xb_ld(&bar[XB_TOPGEN]) == tg, bar);
      __builtin_amdgcn_fence(__ATOMIC_ACQUIRE, "agent");
      xb_add(&bar[XB_XGEN(x)], 1u);
      asm volatile("s_waitcnt vmcnt(0)" ::: "memory");
    } else {
      XB_SPIN(xb_ld(&bar[XB_XGEN(x)]) == gen, bar);
      __builtin_amdgcn_fence(__ATOMIC_ACQUIRE, "agent");
      asm volatile("s_waitcnt vmcnt(0)" ::: "memory");
    }
  }
  __syncthreads();
}

constexpr int SMEM_BYTES = 80896;
#define RUN_PHASE(IDX, CALL)                                                                                                   \
  if (ph0 <= (IDX) && (IDX) < ph1) {                                                                                           \
    int tid; asm volatile("v_mbcnt_lo_u32_b32 %0, -1, 0\n\tv_mbcnt_hi_u32_b32 %0, -1, %0" : "=v"(tid));                        \
    tid |= wave_id << 6;                                                                                                       \
    const __attribute__((address_space(4))) Params* pp = (const __attribute__((address_space(4))) Params*)__builtin_amdgcn_kernarg_segment_ptr(); \
    asm volatile("" : "+s"(pp));                                                                                               \
    const Params& P = *(const Params*)pp;                                                                                      \
    CALL;                                                                                                                      \
    if ((IDX) + 1 < ph1) grid_barrier((unsigned*)(P.ws + OFF_SM + SM_BAR), (volatile unsigned*)(smem + SMEM_BYTES), tid);      \
  }
__global__ void __launch_bounds__(256, 2) mega(Params P_arg, int ph0, int ph1) {
  __shared__ __attribute__((aligned(16))) char smem[SMEM_BYTES + 16];
  const int wave_id = __builtin_amdgcn_readfirstlane(threadIdx.x) >> 6;
  if (ph1 - ph0 > 1) {
    if (threadIdx.x == 0) {
      ((volatile unsigned*)(smem + SMEM_BYTES))[0] = 0u; ((volatile unsigned*)(smem + SMEM_BYTES))[1] = 0u;
      xb_add(&((unsigned*)(P_arg.ws + OFF_SM + SM_BAR))[XB_XCNT(xb_xcc_id())], 1u);
    }
    __syncthreads();
  }
  RUN_PHASE(0, phase_convert(P, 0, smem, tid))
  RUN_PHASE(1, phase_inproj(P, 0, smem, tid))
  RUN_PHASE(2, phase_mix1(P, 0, smem, tid))
  RUN_PHASE(3, phase_mix2(P, 0, tid))
  RUN_PHASE(4, phase_mix3(P, 0, smem, tid))
  RUN_PHASE(5, phase_outproj(P, 0, smem, tid))
  RUN_PHASE(6, phase_ln_router(P, 0, smem, tid))
  RUN_PHASE(7, phase_moe_up(P, 0, smem, tid))
  RUN_PHASE(8, phase_moe_down(P, 0, smem, tid))
  RUN_PHASE(9, phase_ln2(P, 0, smem, tid))
  RUN_PHASE(10, phase_ple(P, 0, smem, tid))
  RUN_PHASE(11, phase_convert(P, 1, smem, tid))
  RUN_PHASE(12, phase_inproj(P, 1, smem, tid))
  RUN_PHASE(13, phase_mix1(P, 1, smem, tid))
  RUN_PHASE(14, phase_mix2(P, 1, tid))
  RUN_PHASE(15, phase_mix3(P, 1, smem, tid))
  RUN_PHASE(16, phase_outproj(P, 1, smem, tid))
  RUN_PHASE(17, phase_ln_router(P, 1, smem, tid))
  RUN_PHASE(18, phase_moe_up(P, 1, smem, tid))
  RUN_PHASE(19, phase_moe_down(P, 1, smem, tid))
  RUN_PHASE(20, phase_ln2(P, 1, smem, tid))
  RUN_PHASE(21, phase_ple(P, 1, smem, tid))
}

extern "C" void kernel_launch(void* const* d_in, const int* in_sizes, int n_in, void* d_out, int out_size, void* d_ws, size_t ws_size, hipStream_t stream) {
  if (ws_size < WS_NEED || n_in < 36) return;
  Params P; memset(&P, 0, sizeof(P));
  const float** f = (const float**)&P;
  (void)f;
  P.x = (const float*)d_in[0]; P.p = (const float*)d_in[1]; P.pos = (const int*)d_in[2]; P.lb_logits = (const float*)d_in[3];
  P.ev_w_in = (const float*)d_in[4]; P.ev_w_out = (const float*)d_in[5]; P.lru_conv_w = (const float*)d_in[6]; P.lru_conv_b = (const float*)d_in[7];
  P.lru_w_r = (const float*)d_in[8]; P.lru_b_r = (const float*)d_in[9]; P.lru_w_i = (const float*)d_in[10]; P.lru_b_i = (const float*)d_in[11];
  P.lru_lambda = (const float*)d_in[12]; P.ret_gn_w = (const float*)d_in[13];
  P.od_w_in = (const float*)d_in[14]; P.od_w_out = (const float*)d_in[15]; P.ssd_conv_w = (const float*)d_in[16]; P.ssd_conv_b = (const float*)d_in[17];
  P.ssd_dt_bias = (const float*)d_in[18]; P.ssd_a_log = (const float*)d_in[19]; P.ssd_d = (const float*)d_in[20]; P.ssd_norm_w = (const float*)d_in[21];
  P.hgrn_norm_w = (const float*)d_in[22];
  P.ln_mix_g = (const float*)d_in[23]; P.ln_mix_b = (const float*)d_in[24]; P.ln_ffn_g = (const float*)d_in[25]; P.ln_ffn_b = (const float*)d_in[26];
  P.moe_w_group = (const float*)d_in[27]; P.moe_b_group = (const float*)d_in[28]; P.moe_w_router = (const float*)d_in[29]; P.moe_b_router = (const float*)d_in[30];
  P.moe_w1 = (const float*)d_in[31]; P.moe_w3 = (const float*)d_in[32]; P.moe_w2 = (const float*)d_in[33]; P.ple_w_proj = (const float*)d_in[34]; P.ple_w_gate = (const float*)d_in[35];
  P.out = (float*)d_out; P.ws = (char*)d_ws;
  for (int ph = 0; ph < 2 * NPH; ++ph) hipLaunchKernelGGL(mega, dim3(512), dim3(256), 0, stream, P, ph, ph + 1);
}
```
